# Optimizing an MI355X kernel written in HIP

```python
import math
import jax, jax.numpy as jnp
from jax import lax
import numpy as np

D_MODEL = 1024
BATCH = 2
SEQ = 8192
DEPTH = 2

CHUNK = 64
N_A = DEPTH // 2
N_B = DEPTH - N_A
EPS = 1e-6

POOL_WINDOWS = (2, 4, 8, 16)
N_POOL = len(POOL_WINDOWS)
POOL_GD = D_MODEL // N_POOL

N_HEADS = 8
QK_NOPE = 128
QK_ROPE = 64
V_DIM = 128
Q_RANK = 384
KV_RANK = 256
ROPE_THETA = 10000.0
ATTN_SCALE = 1.0 / math.sqrt(QK_NOPE + QK_ROPE)
Q_BLOCK = 128

N_GROUPS = 4
EXPERTS_PER_GROUP = 8
N_EXPERTS = N_GROUPS * EXPERTS_PER_GROUP
TOP_K = 2
D_EXPERT = 512
ROW_BLOCK = 256

kernel_name = "yoco_pool_mla_hier_moe"


def rms_norm(x, g):
    xf = x.astype(jnp.float32)
    y = xf * lax.rsqrt(jnp.mean(xf * xf, axis=-1, keepdims=True) + EPS)
    return (y * g.astype(jnp.float32)).astype(x.dtype)


def rope_tables(seq, dtype):
    half = QK_ROPE // 2
    inv = ROPE_THETA ** (-jnp.arange(half, dtype=jnp.float32) / half)
    ang = jnp.arange(seq, dtype=jnp.float32)[:, None] * inv[None, :]
    return jnp.cos(ang).astype(dtype), jnp.sin(ang).astype(dtype)


def apply_rope(x, cos, sin):
    half = QK_ROPE // 2
    x1, x2 = x[..., :half], x[..., half:]
    return jnp.concatenate([x1 * cos - x2 * sin, x2 * cos + x1 * sin], axis=-1)


def pool_mixer(h, w, b, scale):
    B, S, D = h.shape
    hg = h.reshape(B, S, N_POOL, POOL_GD).astype(jnp.float32)
    csum = jnp.pad(jnp.cumsum(hg, axis=1), ((0, 0), (1, 0), (0, 0), (0, 0)))
    t = jnp.arange(S)
    means = []
    for g, win in enumerate(POOL_WINDOWS):
        lo = jnp.maximum(t + 1 - win, 0)
        cnt = (t + 1 - lo).astype(jnp.float32)
        means.append((csum[:, 1:, g] - csum[:, lo, g]) / cnt[:, None])
    pooled = (jnp.stack(means, axis=2) - hg).astype(h.dtype)
    y = jnp.einsum('bsgc,gcd->bsgd', pooled, w) + b
    return y.reshape(B, S, D) * scale


def shared_kv(x, kv_in_norm, w_dkv, kv_norm, w_uk, w_uv, cos, sin):
    B, S, _ = x.shape
    hs = rms_norm(x, kv_in_norm)
    ckv = hs @ w_dkv
    c_kv = rms_norm(ckv[..., :KV_RANK], kv_norm)
    k_rope = apply_rope(ckv[..., KV_RANK:], cos, sin)
    k_nope = (c_kv @ w_uk).reshape(B, S, N_HEADS, QK_NOPE)
    v = (c_kv @ w_uv).reshape(B, S, N_HEADS, V_DIM)
    return k_nope, k_rope, v


def mla_attention(h, k_nope, k_rope, v, wq_down, q_norm, wq_up, wo, cos, sin):
    B, S, _ = h.shape
    cq = rms_norm(h @ wq_down, q_norm)
    q = (cq @ wq_up).reshape(B, S, N_HEADS, QK_NOPE + QK_ROPE)
    q_nope = q[..., :QK_NOPE]
    q_rope = apply_rope(q[..., QK_NOPE:], cos[:, None, :], sin[:, None, :])
    nb = S // Q_BLOCK
    qn_b = q_nope.reshape(B, nb, Q_BLOCK, N_HEADS, QK_NOPE).transpose(1, 0, 2, 3, 4)
    qr_b = q_rope.reshape(B, nb, Q_BLOCK, N_HEADS, QK_ROPE).transpose(1, 0, 2, 3, 4)
    k_chunk = jnp.arange(S) // CHUNK

    def attend(args):
        qn, qr, i = args
        s = (jnp.einsum('bqhd,bkhd->bhqk', qn, k_nope)
             + jnp.einsum('bqhr,bkr->bhqk', qr, k_rope)).astype(jnp.float32) * ATTN_SCALE
        q_chunk = (i * Q_BLOCK + jnp.arange(Q_BLOCK)) // CHUNK
        mask = k_chunk[None, :] <= q_chunk[:, None]
        s = jnp.where(mask[None, None], s, -jnp.inf)
        p = jax.nn.softmax(s, axis=-1).astype(v.dtype)
        return jnp.einsum('bhqk,bkhd->bqhd', p, v)

    o = lax.map(attend, (qn_b, qr_b, jnp.arange(nb)))
    o = o.transpose(1, 0, 2, 3, 4).reshape(B, S, N_HEADS * V_DIM)
    return o @ wo


def hier_moe(h, rg_w, rg_b, re_w, re_b, w_gate, w_up, w_down):
    B, S, D = h.shape
    T = B * S
    ht = h.reshape(T, D)
    gp = jax.nn.softmax((ht @ rg_w + rg_b).astype(jnp.float32), axis=-1)
    g_idx = jnp.argmax(gp, axis=-1)
    g_prob = jnp.take_along_axis(gp, g_idx[:, None], axis=-1)[:, 0]
    el = (ht @ re_w + re_b).astype(jnp.float32).reshape(T, N_GROUPS, EXPERTS_PER_GROUP)
    el = jnp.take_along_axis(el, g_idx[:, None, None], axis=1)[:, 0]
    top_p, top_i = lax.top_k(jax.nn.softmax(el, axis=-1), TOP_K)
    gates = g_prob[:, None] * top_p / jnp.sum(top_p, axis=-1, keepdims=True)
    expert_ids = (g_idx[:, None] * EXPERTS_PER_GROUP + top_i).astype(jnp.int32)

    N = T * TOP_K
    flat_e = expert_ids.reshape(N)
    flat_tok = jnp.arange(N, dtype=jnp.int32) // TOP_K
    flat_g = gates.reshape(N)
    order = jnp.argsort(flat_e, stable=True)
    sorted_e = flat_e[order]
    counts = jnp.bincount(flat_e, length=N_EXPERTS).astype(jnp.int32)
    padded = ((counts + ROW_BLOCK - 1) // ROW_BLOCK) * ROW_BLOCK
    pad_end = jnp.cumsum(padded)
    pad_start = pad_end - padded
    start = jnp.cumsum(counts) - counts
    dest = pad_start[sorted_e] + (jnp.arange(N, dtype=jnp.int32) - start[sorted_e])
    n_blocks = N // ROW_BLOCK + N_EXPERTS
    n_rows = n_blocks * ROW_BLOCK
    row_tok = jnp.zeros((n_rows,), jnp.int32).at[dest].set(flat_tok[order])
    row_w = jnp.zeros((n_rows,), jnp.float32).at[dest].set(flat_g[order])
    block_e = jnp.clip(jnp.searchsorted(pad_end, jnp.arange(n_blocks) * ROW_BLOCK, side='right'),
                       0, N_EXPERTS - 1).astype(jnp.int32)
    xb = ht[row_tok].reshape(n_blocks, ROW_BLOCK, D)

    def expert_block(args):
        xr, e = args
        return (jax.nn.silu(xr @ w_gate[e]) * (xr @ w_up[e])) @ w_down[e]

    y = lax.map(expert_block, (xb, block_e)).reshape(n_rows, D).astype(jnp.float32)
    out = jnp.zeros((T, D), jnp.float32).at[row_tok].add(y * row_w[:, None])
    return out.astype(h.dtype).reshape(B, S, D)


def setup_inputs(seed: int = 0) -> dict:
    key = jax.random.key(seed)
    ks = iter(jax.random.split(key, 32))
    f32 = jnp.float32

    def nrm(shape, fan_in):
        return jax.random.normal(next(ks), shape, f32) * (fan_in ** -0.5)

    def gain(shape):
        return 1.0 + 0.02 * jax.random.normal(next(ks), shape, f32)

    def small(shape, s=0.01):
        return s * jax.random.normal(next(ks), shape, f32)

    return {
        "x": jax.random.normal(next(ks), (BATCH, SEQ, D_MODEL), f32),
        "pool_norm": gain((N_A, D_MODEL)),
        "pool_w": nrm((N_A, N_POOL, POOL_GD, POOL_GD), POOL_GD),
        "pool_b": small((N_A, N_POOL, POOL_GD)),
        "pool_scale": gain((N_A, D_MODEL)),
        "kv_in_norm": gain((D_MODEL,)),
        "w_dkv": nrm((D_MODEL, KV_RANK + QK_ROPE), D_MODEL),
        "kv_norm": gain((KV_RANK,)),
        "w_uk": nrm((KV_RANK, N_HEADS * QK_NOPE), KV_RANK),
        "w_uv": nrm((KV_RANK, N_HEADS * V_DIM), KV_RANK),
        "attn_norm": gain((N_B, D_MODEL)),
        "wq_down": nrm((N_B, D_MODEL, Q_RANK), D_MODEL),
        "q_norm": gain((N_B, Q_RANK)),
        "wq_up": nrm((N_B, Q_RANK, N_HEADS * (QK_NOPE + QK_ROPE)), Q_RANK),
        "wo": nrm((N_B, N_HEADS * V_DIM, D_MODEL), N_HEADS * V_DIM),
        "ffn_norm": gain((DEPTH, D_MODEL)),
        "router_group_w": nrm((DEPTH, D_MODEL, N_GROUPS), D_MODEL),
        "router_group_b": small((DEPTH, N_GROUPS)),
        "router_expert_w": nrm((DEPTH, D_MODEL, N_EXPERTS), D_MODEL),
        "router_expert_b": small((DEPTH, N_EXPERTS)),
        "w_gate": nrm((DEPTH, N_EXPERTS, D_MODEL, D_EXPERT), D_MODEL),
        "w_up": nrm((DEPTH, N_EXPERTS, D_MODEL, D_EXPERT), D_MODEL),
        "w_down": nrm((DEPTH, N_EXPERTS, D_EXPERT, D_MODEL), D_EXPERT),
        "final_norm": gain((D_MODEL,)),
    }


def reference(x, pool_norm, pool_w, pool_b, pool_scale, kv_in_norm, w_dkv, kv_norm, w_uk, w_uv,
              attn_norm, wq_down, q_norm, wq_up, wo, ffn_norm, router_group_w, router_group_b,
              router_expert_w, router_expert_b, w_gate, w_up, w_down, final_norm):
    S = x.shape[1]
    cos, sin = rope_tables(S, x.dtype)
    k_nope = k_rope = v = None
    for l in range(DEPTH):
        if l < N_A:
            x = x + pool_mixer(rms_norm(x, pool_norm[l]), pool_w[l], pool_b[l], pool_scale[l])
        else:
            if l == N_A:
                k_nope, k_rope, v = shared_kv(x, kv_in_norm, w_dkv, kv_norm, w_uk, w_uv, cos, sin)
            j = l - N_A
            x = x + mla_attention(rms_norm(x, attn_norm[j]), k_nope, k_rope, v,
                                  wq_down[j], q_norm[j], wq_up[j], wo[j], cos, sin)
        x = x + hier_moe(rms_norm(x, ffn_norm[l]), router_group_w[l], router_group_b[l],
                         router_expert_w[l], router_expert_b[l], w_gate[l], w_up[l], w_down[l])
    return rms_norm(x, final_norm)
```

```cpp
#include <hip/hip_runtime.h>
#include <stdint.h>
#include <stdio.h>
#define PROBE_LAST 15
#define PROBE_VALU6 1

#define DEVI __device__ __forceinline__
typedef unsigned short bf16_t;
typedef short bf16x8 __attribute__((ext_vector_type(8)));
typedef float f32x4 __attribute__((ext_vector_type(4)));
typedef float f32x2 __attribute__((ext_vector_type(2)));
typedef unsigned u32x4 __attribute__((ext_vector_type(4)));
typedef unsigned u32x2 __attribute__((ext_vector_type(2)));

constexpr int T_TOK = 16384, SEQ = 8192, DM = 1024;
constexpr int NEXP = 32, DEXP = 512;
constexpr int NH = 8, DQK = 192, DNOPE = 128, DROPE = 64, DV = 128, QRANK = 384, KVRANK = 256;
constexpr float EPS = 1e-6f;
constexpr float QSCALE = 0.10411754627697266f;
constexpr int NWAVES = 8, NTHREADS = 512;
constexpr int LDS_BYTES = 147456, MISC_OFF = 147456 - 64;

constexpr size_t MiB = 1u << 20;
constexpr size_t WS_CTL = 0, CTL_ZERO_BYTES = 65536;
constexpr size_t WS_WPOOL = 1 * MiB, WS_WDOWN = 2 * MiB, WS_WUPKV = 4 * MiB, WS_WUPQ = 5 * MiB, WS_WO = 7 * MiB;
constexpr size_t WS_WR = 9 * MiB;
constexpr size_t WS_PBIAS = 9 * MiB + 512 * 1024;
constexpr size_t WS_ROPE = 10 * MiB;
constexpr size_t WS_WH = 12 * MiB;
constexpr size_t WS_CNT = 12 * MiB + 64 * 1024;
constexpr size_t WS_TOKR = 13 * MiB;
constexpr size_t WS_W1 = 16 * MiB, WS_W2 = 144 * MiB;
constexpr size_t WS_X = 208 * MiB, WS_XB = 272 * MiB;
constexpr size_t WS_XG = 304 * MiB, WS_H = 384 * MiB, WS_Y = 424 * MiB;
constexpr size_t WS_PB = 304 * MiB;
constexpr size_t WS_Q = 304 * MiB, WS_KN = 352 * MiB, WS_V = 384 * MiB, WS_O = 416 * MiB;
constexpr size_t WS_CKV = 448 * MiB, WS_CQ = 456 * MiB, WS_KR = 468 * MiB;
constexpr size_t WS_RI = 488 * MiB;
constexpr size_t WS_RS = 489 * MiB;
constexpr size_t WS_RS2 = 489 * MiB + 64 * 1024;
constexpr size_t WS_SSKV = 490 * MiB;
constexpr size_t WS_SSQ = 490 * MiB + 256 * 1024;
constexpr size_t WS_END = 492 * MiB;
constexpr int MAXTILES = 160;

constexpr int CW_CNT = 1024;
constexpr int CW_BAR = 4096;

struct Args { const float* in[24]; float* out; unsigned char* ws; int ph_lo, ph_hi, li, pad; };

typedef __bf16 bf16x2_t __attribute__((ext_vector_type(2)));
DEVI unsigned cvt_pk(float lo, float hi) { const f32x2 v = {lo, hi}; return __builtin_bit_cast(unsigned, __builtin_convertvector(v, bf16x2_t)); }
DEVI float bf2f(unsigned short b) { return __uint_as_float((unsigned)b << 16); }
DEVI float bflo(unsigned w) { return __uint_as_float(w << 16); }
DEVI float bfhi(unsigned w) { return __uint_as_float(w & 0xffff0000u); }
DEVI float wave_sum(float v) {
#pragma unroll
    for (int o = 1; o < 64; o <<= 1) v += __shfl_xor(v, o);
    return v;
}
DEVI float wave_max(float v) {
#pragma unroll
    for (int o = 1; o < 64; o <<= 1) v = fmaxf(v, __shfl_xor(v, o));
    return v;
}
DEVI u32x4 pack8(f32x4 a, f32x4 b) { u32x4 w; w.x = cvt_pk(a[0], a[1]); w.y = cvt_pk(a[2], a[3]); w.z = cvt_pk(b[0], b[1]); w.w = cvt_pk(b[2], b[3]); return w; }

struct Unit { const bf16_t* A; const bf16_t* B; int pm, pn; };
struct GemmDesc { int lda, ldb, K; };

struct SchedDense {
    const bf16_t* A; const bf16_t* B; int lda, nM, nN, G, c; size_t a_pn_off, b_pn_off;
    DEVI bool next(int i, Unit& u) const {
        const int L = i * G + c; if (L >= nM * nN) return false;
        u.pm = L / nN; u.pn = L - u.pm * nN;
        u.A = A + (size_t)u.pm * 256 * lda + (size_t)u.pn * a_pn_off; u.B = B + (size_t)u.pn * b_pn_off; return true;
    }
};
struct SchedMoE {
    const bf16_t* A; const bf16_t* W; const int* tstart; int lda, ldb, NT, G, c;
    DEVI bool next(int i, Unit& u) const {
        const int L = i * G + c; if (L >= NT * 4) return false;
        u.pm = L >> 2; u.pn = L & 3; int e = 0;
        for (int k = 1; k < NEXP; ++k) e += (tstart[k] <= u.pm) ? 1 : 0;
        u.A = A + (size_t)u.pm * 256 * lda; u.B = W + ((size_t)e * 1024 + (size_t)u.pn * 256) * ldb; return true;
    }
};

template <class Epi, class Sched>
DEVI void gemm_phase_naive(const GemmDesc g, const Sched& S, const Epi& E) {
    const int tid = threadIdx.x, wid = __builtin_amdgcn_readfirstlane(tid >> 6), lane = tid & 63, wr = wid >> 2, wc = wid & 3, fr = lane & 15, fq = lane >> 4;
    Unit u;
    for (int i = 0; S.next(i, u); ++i) {
        f32x4 acc[2][2][4][2];
#pragma unroll
        for (int a = 0; a < 2; ++a)
#pragma unroll
            for (int b = 0; b < 2; ++b)
#pragma unroll
                for (int m = 0; m < 4; ++m)
#pragma unroll
                    for (int n = 0; n < 2; ++n) acc[a][b][m][n] = (f32x4){0.f, 0.f, 0.f, 0.f};
        const bf16_t* a0 = u.A + (size_t)(wr * 64 + fr) * g.lda + fq * 8;
        const bf16_t* b0 = u.B + (size_t)(wc * 32 + 8 * (fr >> 2) + (fr & 3)) * g.ldb + fq * 8;
#pragma unroll 1
        for (int k = 0; k < g.K; k += 32) {
            bf16x8 av[2][4], bv[2][2];
#pragma unroll
            for (int ai = 0; ai < 2; ++ai)
#pragma unroll
                for (int m = 0; m < 4; ++m) av[ai][m] = *(const bf16x8*)(a0 + (size_t)(ai * 128 + m * 16) * g.lda + k);
#pragma unroll
            for (int bj = 0; bj < 2; ++bj)
#pragma unroll
                for (int n = 0; n < 2; ++n) bv[bj][n] = *(const bf16x8*)(b0 + (size_t)(bj * 128 + 4 * n) * g.ldb + k);
#pragma unroll
            for (int ai = 0; ai < 2; ++ai)
#pragma unroll
                for (int bj = 0; bj < 2; ++bj)
#pragma unroll
                    for (int m = 0; m < 4; ++m)
#pragma unroll
                        for (int n = 0; n < 2; ++n) acc[ai][bj][m][n] = __builtin_amdgcn_mfma_f32_16x16x32_bf16(bv[bj][n], av[ai][m], acc[ai][bj][m][n], 0, 0, 0);
        }
        E(acc, u, wr, wc, fr, fq);
    }
}

DEVI void opaque(unsigned& x) { asm volatile("" : "+v"(x)); }
#define EPI_ROWS_BEGIN(r0) { unsigned row_ = (r0); _Pragma("unroll") for (int ai = 0; ai < 2; ++ai) { _Pragma("unroll") for (int m = 0; m < 4; ++m) { opaque(row_); const unsigned row = row_;
#define EPI_ROWS_END row_ += 16u; } row_ += 64u; } }

struct EpiPool {
    const float* xin; const float* bias; float* X; bf16_t* XB;
    DEVI void operator()(const f32x4 (&acc)[2][2][4][2], const Unit& u, int wr, int wc, int fr, int fq) const {
        const unsigned col0 = u.pn * 256 + wc * 32 + 8 * fq;
        f32x4 bv[2][2];
#pragma unroll
        for (int bj = 0; bj < 2; ++bj) { bv[bj][0] = *(const f32x4*)(bias + col0 + bj * 128); bv[bj][1] = *(const f32x4*)(bias + col0 + bj * 128 + 4); }
        EPI_ROWS_BEGIN(u.pm * 256 + wr * 64 + fr)
            const unsigned off = row * DM + col0;
#pragma unroll
            for (int bj = 0; bj < 2; ++bj) {
                const unsigned o = off + bj * 128;
                const f32x4 x0 = *(const f32x4*)(xin + o), x1 = *(const f32x4*)(xin + o + 4);
                const f32x4 v0 = acc[ai][bj][m][0] + bv[bj][0] + x0, v1 = acc[ai][bj][m][1] + bv[bj][1] + x1;
                *(f32x4*)(X + o) = v0; *(f32x4*)(X + o + 4) = v1;
                *(u32x4*)(XB + o) = pack8(v0, v1);
            }
        EPI_ROWS_END
    }
};
struct EpiSwiGLU {
    const u32x4* RI; bf16_t* H;
    DEVI void operator()(const f32x4 (&acc)[2][2][4][2], const Unit& u, int wr, int wc, int fr, int fq) const {
        const unsigned col0 = (u.pn * 256 + wc * 32 + 8 * fq) >> 1;
        EPI_ROWS_BEGIN(u.pm * 256 + wr * 64 + fr)
            const float rstd = __uint_as_float(RI[row].z);
#pragma unroll
            for (int bj = 0; bj < 2; ++bj) {
                const f32x4 gv = acc[ai][bj][m][0] * rstd, uv = acc[ai][bj][m][1] * rstd;
                float h[4];
#pragma unroll
                for (int j = 0; j < 4; ++j) h[j] = gv[j] / (1.f + __expf(-gv[j])) * uv[j];
                u32x2 w; w.x = cvt_pk(h[0], h[1]); w.y = cvt_pk(h[2], h[3]);
                *(u32x2*)(H + row * DEXP + col0 + bj * 64) = w;
            }
        EPI_ROWS_END
    }
};
struct EpiMoeDown {
    const u32x4* RI; bf16_t* Y;
    DEVI void operator()(const f32x4 (&acc)[2][2][4][2], const Unit& u, int wr, int wc, int fr, int fq) const {
        const unsigned col0 = u.pn * 256 + wc * 32 + 8 * fq;
        EPI_ROWS_BEGIN(u.pm * 256 + wr * 64 + fr)
            const u32x4 ri = RI[row]; const int dest = (int)ri.x; const float w = __uint_as_float(ri.y);
            if (dest >= 0) {
                const unsigned o = ((unsigned)(dest & 1) * T_TOK + (unsigned)(dest >> 1)) * DM + col0;
#pragma unroll
                for (int bj = 0; bj < 2; ++bj) *(u32x4*)(Y + o + bj * 128) = pack8(acc[ai][bj][m][0] * w, acc[ai][bj][m][1] * w);
            }
        EPI_ROWS_END
    }
};
DEVI float sumsq8(f32x4 a, f32x4 b) { return ((a[0] * a[0] + a[1] * a[1]) + (a[2] * a[2] + a[3] * a[3])) + ((b[0] * b[0] + b[1] * b[1]) + (b[2] * b[2] + b[3] * b[3])); }
DEVI void rope4(f32x4 v0, f32x4 v1, f32x4 c, f32x4 s, u32x2& w1, u32x2& w2) {
    const float a1[4] = {v0[0], v0[2], v1[0], v1[2]}, a2[4] = {v0[1], v0[3], v1[1], v1[3]};
    float o1[4], o2[4];
#pragma unroll
    for (int j = 0; j < 4; ++j) { o1[j] = a1[j] * c[j] - a2[j] * s[j]; o2[j] = a2[j] * c[j] + a1[j] * s[j]; }
    w1.x = cvt_pk(o1[0], o1[1]); w1.y = cvt_pk(o1[2], o1[3]); w2.x = cvt_pk(o2[0], o2[1]); w2.y = cvt_pk(o2[2], o2[3]);
}
struct EpiDownProj {
    const float* RS2; bf16_t* CKV; bf16_t* CQ; bf16_t* KR; float* SSKV; float* SSQ; const float* ropec; const float* ropes;
    DEVI void operator()(const f32x4 (&acc)[2][2][4][2], const Unit& u, int wr, int wc, int fr, int fq) const {
        const unsigned colw = wc * 32 + 8 * fq;
        EPI_ROWS_BEGIN(u.pm * 256 + wr * 64 + fr)
            const float rstd = RS2[row];
            float ss = 0.f;
#pragma unroll
            for (int bj = 0; bj < 2; ++bj) {
                const unsigned col = bj * 128 + colw;
                const f32x4 v0 = acc[ai][bj][m][0] * rstd, v1 = acc[ai][bj][m][1] * rstd;
                if (u.pn == 0) { ss += sumsq8(v0, v1); *(u32x4*)(CKV + row * KVRANK + col) = pack8(v0, v1); }
                else if (u.pn == 1 && col < 64) {
                    const unsigned i0 = col >> 1, pos = row & (SEQ - 1);
                    const f32x4 c = *(const f32x4*)(ropec + pos * 32 + i0), s = *(const f32x4*)(ropes + pos * 32 + i0);
                    u32x2 w1, w2; rope4(v0, v1, c, s, w1, w2);
                    *(u32x2*)(KR + row * DROPE + i0) = w1; *(u32x2*)(KR + row * DROPE + 32 + i0) = w2;
                } else {
                    const unsigned cq = u.pn * 256 + col - 320;
                    if (cq < (unsigned)QRANK) { ss += sumsq8(v0, v1); *(u32x4*)(CQ + row * QRANK + cq) = pack8(v0, v1); }
                }
            }
            ss += __shfl_xor(ss, 16); ss += __shfl_xor(ss, 32);
            if (fq == 0) { if (u.pn == 0) SSKV[row * 4 + wc] = ss; else SSQ[row * 8 + (u.pn - 1) * 4 + wc] = ss; }
        EPI_ROWS_END
    }
};
struct EpiUpKV {
    const float* SSKV; bf16_t* KN; bf16_t* V;
    DEVI void operator()(const f32x4 (&acc)[2][2][4][2], const Unit& u, int wr, int wc, int fr, int fq) const {
        bf16_t* base = (u.pn < 4) ? KN : V;
        const unsigned h0 = (u.pn & 3) * 2, d = wc * 32 + 8 * fq;
        EPI_ROWS_BEGIN(u.pm * 256 + wr * 64 + fr)
            const f32x4 sp = *(const f32x4*)(SSKV + row * 4);
            const float rstd = rsqrtf(((sp[0] + sp[1]) + (sp[2] + sp[3])) * (1.f / KVRANK) + EPS);
            const unsigned b = row >> 13, s = row & (SEQ - 1);
#pragma unroll
            for (int bj = 0; bj < 2; ++bj)
                *(u32x4*)(base + (((b * NH + h0 + bj) * SEQ + s) * 128 + d)) = pack8(acc[ai][bj][m][0] * rstd, acc[ai][bj][m][1] * rstd);
        EPI_ROWS_END
    }
};
struct EpiUpQ {
    const float* SSQ; bf16_t* Q; const float* ropec; const float* ropes;
    DEVI void operator()(const f32x4 (&acc)[2][2][4][2], const Unit& u, int wr, int wc, int fr, int fq) const {
        unsigned hh[2], jj[2];
#pragma unroll
        for (int bj = 0; bj < 2; ++bj) { const unsigned n = u.pn * 256 + bj * 128 + wc * 32 + 8 * fq; hh[bj] = n / DQK; jj[bj] = n - hh[bj] * DQK; }
        EPI_ROWS_BEGIN(u.pm * 256 + wr * 64 + fr)
            const f32x4 sa = *(const f32x4*)(SSQ + row * 8), sb = *(const f32x4*)(SSQ + row * 8 + 4);
            const float rstd = rsqrtf((((sa[0] + sa[1]) + (sa[2] + sa[3])) + ((sb[0] + sb[1]) + (sb[2] + sb[3]))) * (1.f / QRANK) + EPS);
            const unsigned b = row >> 13, s = row & (SEQ - 1);
#pragma unroll
            for (int bj = 0; bj < 2; ++bj) {
                bf16_t* qrow = Q + ((b * NH + hh[bj]) * SEQ + s) * DQK;
                const f32x4 v0 = acc[ai][bj][m][0] * rstd, v1 = acc[ai][bj][m][1] * rstd;
                if (jj[bj] < (unsigned)DNOPE) { *(u32x4*)(qrow + jj[bj]) = pack8(v0, v1); }
                else {
                    const unsigned i0 = (jj[bj] - DNOPE) >> 1;
                    const f32x4 c = *(const f32x4*)(ropec + s * 32 + i0), sn = *(const f32x4*)(ropes + s * 32 + i0);
                    u32x2 w1, w2; rope4(v0, v1, c, sn, w1, w2);
                    *(u32x2*)(qrow + DNOPE + i0) = w1; *(u32x2*)(qrow + DNOPE + 32 + i0) = w2;
                }
            }
        EPI_ROWS_END
    }
};
struct EpiWo {
    float* X; bf16_t* XB;
    DEVI void operator()(const f32x4 (&acc)[2][2][4][2], const Unit& u, int wr, int wc, int fr, int fq) const {
        const unsigned col0 = u.pn * 256 + wc * 32 + 8 * fq;
        EPI_ROWS_BEGIN(u.pm * 256 + wr * 64 + fr)
            const unsigned off = row * DM + col0;
#pragma unroll
            for (int bj = 0; bj < 2; ++bj) {
                const unsigned o = off + bj * 128;
                const f32x4 v0 = *(const f32x4*)(X + o) + acc[ai][bj][m][0], v1 = *(const f32x4*)(X + o + 4) + acc[ai][bj][m][1];
                *(f32x4*)(X + o) = v0; *(f32x4*)(X + o + 4) = v1;
                *(u32x4*)(XB + o) = pack8(v0, v1);
            }
        EPI_ROWS_END
    }
};

struct ConvJob { const float* src; const float* gain; const float* cvec; bf16_t* dst; int ldsrc, lddst, k0, n0, width, map, mparam; float cscale; };
DEVI int dst_row(int map, int mparam, int n) {
    if (map == 0) return n + mparam;
    if (map == 1) return 8 * (n >> 2) + (n & 3) + mparam;
    if (map == 3) { const int p = n - 256; return 256 + 2 * (p & 31) + (p >> 5); }
    const int h = n / DQK, j = n - h * DQK; if (j < DNOPE) return n; const int p = j - DNOPE; return h * DQK + DNOPE + 2 * (p & 31) + (p >> 5);
}
constexpr int NCONV_EXP = 64 * 96, NCONV_SMALL = 212, NCONV = NCONV_EXP + NCONV_SMALL;
DEVI void conv_decode(const Args& a, int t, ConvJob& j) {
    unsigned char* ws = a.ws;
    j.gain = nullptr; j.cvec = nullptr; j.cscale = 1.f; j.width = 256; j.map = 0; j.mparam = 0;
    if (t < NCONV_EXP) {
        const int le = t / 96, r = t - le * 96, l = le >> 5;
        if (r < 64) { const int rr = r & 31, up = r >> 5; j.src = a.in[up ? 21 : 20] + (size_t)le * 1024 * 512; j.ldsrc = 512; j.k0 = (rr >> 1) * 64; j.n0 = (rr & 1) * 256;
            j.gain = a.in[15] + l * 1024; j.dst = (bf16_t*)(ws + WS_W1) + (size_t)le * 1024 * 1024; j.lddst = 1024; j.map = 1; j.mparam = up ? 4 : 0; }
        else { const int rr = r - 64; j.src = a.in[22] + (size_t)le * 512 * 1024; j.ldsrc = 1024; j.k0 = (rr >> 2) * 64; j.n0 = (rr & 3) * 256;
            j.dst = (bf16_t*)(ws + WS_W2) + (size_t)le * 1024 * 512; j.lddst = 512; }
        return;
    }
    t -= NCONV_EXP;
    if (t < 16) { const int g = t >> 2; j.src = a.in[2] + g * 65536; j.ldsrc = 256; j.k0 = (t & 3) * 64; j.n0 = 0; j.gain = a.in[1] + g * 256; j.cvec = a.in[4] + g * 256;
        j.dst = (bf16_t*)(ws + WS_WPOOL) + g * 65536; j.lddst = 256; return; }
    t -= 16;
    if (t < 32) { const int nt = t & 1; j.src = a.in[6]; j.ldsrc = 320; j.k0 = (t >> 1) * 64; j.n0 = nt * 256; j.width = nt ? 64 : 256; j.gain = a.in[5];
        j.dst = (bf16_t*)(ws + WS_WDOWN); j.lddst = 1024; j.map = nt ? 3 : 0; return; }
    t -= 32;
    if (t < 32) { const int nt = t & 1; j.src = a.in[11]; j.ldsrc = 384; j.k0 = (t >> 1) * 64; j.n0 = nt * 256; j.width = nt ? 128 : 256; j.gain = a.in[10];
        j.dst = (bf16_t*)(ws + WS_WDOWN); j.lddst = 1024; j.mparam = 320; return; }
    t -= 32;
    if (t < 32) { const int uv = t >> 4, tt = t & 15; j.src = a.in[uv ? 9 : 8]; j.ldsrc = 1024; j.k0 = (tt >> 2) * 64; j.n0 = (tt & 3) * 256; j.gain = a.in[7];
        j.dst = (bf16_t*)(ws + WS_WUPKV); j.lddst = 256; j.mparam = uv ? 1024 : 0; return; }
    t -= 32;
    if (t < 36) { j.src = a.in[13]; j.ldsrc = 1536; j.k0 = (t / 6) * 64; j.n0 = (t % 6) * 256; j.gain = a.in[12]; j.cscale = QSCALE;
        j.dst = (bf16_t*)(ws + WS_WUPQ); j.lddst = 384; j.map = 4; return; }
    t -= 36;
    j.src = a.in[14]; j.ldsrc = 1024; j.k0 = (t >> 2) * 64; j.n0 = (t & 3) * 256; j.dst = (bf16_t*)(ws + WS_WO); j.lddst = 1024;
}
DEVI void conv_tile(const ConvJob& j, float* tile) {
    const int tid = threadIdx.x, w = tid >> 6, lane = tid & 63, n4 = lane * 4;
    if (n4 < j.width) {
#pragma unroll
        for (int i = 0; i < 8; ++i) { const int k = w + 8 * i;
            f32x4 v = *(const f32x4*)(j.src + (size_t)(j.k0 + k) * j.ldsrc + j.n0 + n4);
            const float g = j.gain ? j.gain[j.k0 + k] : 1.f;
            float* tp = tile + k * 257 + n4; tp[0] = v[0] * g; tp[1] = v[1] * g; tp[2] = v[2] * g; tp[3] = v[3] * g; }
    }
    __syncthreads();
#pragma unroll
    for (int i = 0; i < 4; ++i) { const int q = tid + 512 * i, kp = q & 7, nl = q >> 3;
        if (nl < j.width) {
            const float cs = j.cscale * (j.cvec ? j.cvec[j.n0 + nl] : 1.f);
            const float* tp = tile + (8 * kp) * 257 + nl;
            u32x4 o; o.x = cvt_pk(tp[0] * cs, tp[257] * cs); o.y = cvt_pk(tp[2 * 257] * cs, tp[3 * 257] * cs); o.z = cvt_pk(tp[4 * 257] * cs, tp[5 * 257] * cs); o.w = cvt_pk(tp[6 * 257] * cs, tp[7 * 257] * cs);
            const int row = dst_row(j.map, j.mparam, j.n0 + nl);
            *(u32x4*)(j.dst + (size_t)row * j.lddst + j.k0 + 8 * kp) = o;
        }
    }
    __syncthreads();
}
__device__ const double ROPE_THETA_TAB[32] = {1.0, 0.7498942093324559, 0.5623413251903491, 0.4216965034285822, 0.31622776601683794, 0.23713737056616552, 0.1778279410038923, 0.1333521432163324, 0.1, 0.07498942093324558, 0.05623413251903491, 0.042169650342858224, 0.03162277660168379, 0.023713737056616554, 0.01778279410038923, 0.01333521432163324, 0.01, 0.007498942093324558, 0.005623413251903491, 0.004216965034285823, 0.0031622776601683794, 0.0023713737056616554, 0.0017782794100389228, 0.001333521432163324, 0.001, 0.0007498942093324559, 0.0005623413251903491, 0.00042169650342858224, 0.00031622776601683794, 0.00023713737056616554, 0.00017782794100389227, 0.0001333521432163324};
DEVI void sincos_d(double a, float& sn, float& cs) {
    const double t = a * 0.15915494309189535;
    const double fr = t - __builtin_rint(t);
    const double q = __builtin_rint(fr * 4.0);
    const double y = (fr - q * 0.25) * 6.283185307179586;
    const double y2 = y * y;
    double s = y * (1.0 + y2 * (-1.0 / 6 + y2 * (1.0 / 120 + y2 * (-1.0 / 5040 + y2 * (1.0 / 362880 + y2 * (-1.0 / 39916800 + y2 * (1.0 / 6227020800.0)))))));
    double c = 1.0 + y2 * (-0.5 + y2 * (1.0 / 24 + y2 * (-1.0 / 720 + y2 * (1.0 / 40320 + y2 * (-1.0 / 3628800 + y2 * (1.0 / 479001600.0))))));
    const int qi = ((int)q) & 3;
    double so, co;
    if (qi == 0) { so = s; co = c; } else if (qi == 1) { so = c; co = -s; } else if (qi == 2) { so = -s; co = -c; } else { so = -c; co = s; }
    sn = (float)so; cs = (float)co;
}
DEVI void phase_prologue(const Args& a, unsigned char* lds) {
    float* tile = (float*)lds;
    for (int t = blockIdx.x; t < NCONV; t += gridDim.x) { ConvJob j; conv_decode(a, t, j); conv_tile(j, tile); }
    const int gtid = blockIdx.x * NTHREADS + threadIdx.x, gn = gridDim.x * NTHREADS;
    unsigned char* ws = a.ws;
    { u32x4* z = (u32x4*)((bf16_t*)(ws + WS_WDOWN) + 704 * 1024); for (int i = gtid; i < 64 * 1024 * 2 / 16; i += gn) z[i] = (u32x4){0u, 0u, 0u, 0u}; }
    { float* wr = (float*)(ws + WS_WR);
      for (int i = gtid; i < 2 * 36 * 1024; i += gn) { const int l = i / (36 * 1024), r = i - l * 36 * 1024, jj = r >> 10, k = r & 1023;
          const float g = a.in[15][l * 1024 + k];
          wr[i] = g * (jj < 4 ? a.in[16][(size_t)(l * 1024 + k) * 4 + jj] : a.in[18][(size_t)(l * 1024 + k) * 32 + (jj - 4)]); } }
    { float* pb = (float*)(ws + WS_PBIAS); for (int i = gtid; i < 1024; i += gn) pb[i] = a.in[3][i] * a.in[4][i]; }
    { float* rc = (float*)(ws + WS_ROPE); float* rs = rc + SEQ * 32;
      for (int i = gtid; i < SEQ * 32; i += gn) { const int pos = i >> 5, k = i & 31; const float th = (float)ROPE_THETA_TAB[k]; const float ang = (float)pos * th;
          float sn, cs; sincos_d((double)ang, sn, cs); rc[i] = cs; rs[i] = sn; } }
}

template <int WIN>
DEVI void pool_channel(const float* xc, int pos0, const float* rstd, bf16_t* outc) {
    float ring[16];
#pragma unroll
    for (int u = 0; u < 16; ++u) ring[u] = 0.f;
    float P = 0.f;
    for (int blk = 0; blk < 5; ++blk) {
#pragma unroll
        for (int u = 0; u < 16; ++u) {
            const int rr = blk * 16 + u;
            if (rr < 79) {
                const int pos = pos0 - 15 + rr;
                const float v = (pos >= 0) ? xc[(long)pos * DM] * rstd[rr] : 0.f;
                P += v;
                const float Pold = ring[(u - WIN) & 15];
                ring[u] = P;
                if (rr >= 15) { const int cnt = (pos + 1 < WIN) ? pos + 1 : WIN; const float mean = (P - Pold) / (float)cnt;
                    outc[(long)(rr - 15) * DM] = (bf16_t)(cvt_pk(mean - v, 0.f) & 0xffffu); }
            }
        }
    }
}
DEVI void phase_pool_prep(const Args& a, unsigned char* lds) {
    const float* x = a.in[0]; bf16_t* PB = (bf16_t*)(a.ws + WS_PB);
    float* rstd = (float*)lds;
    const int tid = threadIdx.x, wid = tid >> 6, lane = tid & 63;
    for (int c = blockIdx.x; c < T_TOK / 64; c += gridDim.x) {
        const int b = c >> 7, pos0 = (c & 127) * 64;
        const float* xb = x + (size_t)b * SEQ * DM;
        for (int rr = wid; rr < 79; rr += NWAVES) {
            const int pos = pos0 - 15 + rr; float r = 0.f;
            if (pos >= 0) { const f32x4* xr = (const f32x4*)(xb + (size_t)pos * DM) + lane; float s = 0.f;
#pragma unroll
                for (int j = 0; j < 4; ++j) { const f32x4 v = xr[64 * j]; s += (v[0] * v[0] + v[1] * v[1]) + (v[2] * v[2] + v[3] * v[3]); }
                r = rsqrtf(wave_sum(s) * (1.f / DM) + EPS); }
            if (lane == 0) rstd[rr] = r;
        }
        __syncthreads();
#pragma unroll
        for (int pass = 0; pass < 2; ++pass) {
            const int ch = tid + 512 * pass, g = __builtin_amdgcn_readfirstlane(ch >> 8);
            const float* xc = xb + ch; bf16_t* oc = PB + ((size_t)b * SEQ + pos0) * DM + ch;
            if (g == 0) pool_channel<2>(xc, pos0, rstd, oc); else if (g == 1) pool_channel<4>(xc, pos0, rstd, oc);
            else if (g == 2) pool_channel<8>(xc, pos0, rstd, oc); else pool_channel<16>(xc, pos0, rstd, oc);
        }
        __syncthreads();
    }
}

DEVI void phase_route(const Args& a, int layer, unsigned char* lds) {
    const float* X = (const float*)(a.ws + WS_X);
    const float* Wr = (const float*)(a.ws + WS_WR) + layer * 36 * 1024;
    const float* bg = a.in[17] + layer * 4; const float* be = a.in[19] + layer * 32;
    unsigned* WH = (unsigned*)(a.ws + WS_WH);
    u32x4* TOKR = (u32x4*)(a.ws + WS_TOKR);
    float* lg = (float*)lds;
    int* ea = (int*)(lds + 4 * 16 * 40 * 4);
    int* eb = ea + 64;
    const int tid = threadIdx.x, wid = tid >> 6, lane = tid & 63;
    for (int unit = blockIdx.x; unit < T_TOK / 64; unit += gridDim.x) {
        int e0 = 0, e1 = 0; float w0 = 0.f, w1 = 0.f, rstd_t = 0.f;
        if (wid < 4) {
            const int tok0 = unit * 64 + wid * 16, r = lane & 15, kq = lane >> 4;
            const float* xr = X + (size_t)(tok0 + r) * DM + 4 * kq;
            const int c2 = (32 + r < 36) ? 32 + r : 35;
            const float* wp0 = Wr + (size_t)r * 1024 + 4 * kq; const float* wp1 = Wr + (size_t)(16 + r) * 1024 + 4 * kq; const float* wp2 = Wr + (size_t)c2 * 1024 + 4 * kq;
            f32x4 acc0 = {0.f, 0.f, 0.f, 0.f}, acc1 = acc0, acc2 = acc0; float ss = 0.f;
            for (int s = 0; s < 64; ++s) {
                const f32x4 xv = *(const f32x4*)(xr + 16 * s), a0 = *(const f32x4*)(wp0 + 16 * s), a1 = *(const f32x4*)(wp1 + 16 * s), a2 = *(const f32x4*)(wp2 + 16 * s);
                ss += (xv[0] * xv[0] + xv[1] * xv[1]) + (xv[2] * xv[2] + xv[3] * xv[3]);
#pragma unroll
                for (int uu = 0; uu < 4; ++uu) {
                    acc0 = __builtin_amdgcn_mfma_f32_16x16x4f32(xv[uu], a0[uu], acc0, 0, 0, 0);
                    acc1 = __builtin_amdgcn_mfma_f32_16x16x4f32(xv[uu], a1[uu], acc1, 0, 0, 0);
                    acc2 = __builtin_amdgcn_mfma_f32_16x16x4f32(xv[uu], a2[uu], acc2, 0, 0, 0);
                }
            }
            ss += __shfl_xor(ss, 16); ss += __shfl_xor(ss, 32);
            const float rstd = rsqrtf(ss * (1.f / DM) + EPS);
            float* lw = lg + wid * 16 * 40;
#pragma unroll
            for (int j = 0; j < 4; ++j) { const int trow = 4 * kq + j; lw[trow * 40 + r] = acc0[j]; lw[trow * 40 + 16 + r] = acc1[j]; if (r < 4) lw[trow * 40 + 32 + r] = acc2[j]; }
            asm volatile("s_waitcnt lgkmcnt(0)" ::: "memory");
            if (lane < 16) {
                const float* L = lw + lane * 40;
                float gl[4];
#pragma unroll
                for (int j = 0; j < 4; ++j) gl[j] = L[j] * rstd + bg[j];
                int gi = 0; float gm = gl[0];
#pragma unroll
                for (int j = 1; j < 4; ++j) if (gl[j] > gm) { gm = gl[j]; gi = j; }
                float den = 0.f;
#pragma unroll
                for (int j = 0; j < 4; ++j) den += __expf(gl[j] - gm);
                const float gprob = 1.f / den;
                float el[8];
#pragma unroll
                for (int j = 0; j < 8; ++j) el[j] = L[4 + 8 * gi + j] * rstd + be[8 * gi + j];
                int ia = 0; float ma = el[0];
#pragma unroll
                for (int j = 1; j < 8; ++j) if (el[j] > ma) { ma = el[j]; ia = j; }
                int ib = -1; float mb = -3.0e38f;
#pragma unroll
                for (int j = 0; j < 8; ++j) if (j != ia && el[j] > mb) { mb = el[j]; ib = j; }
                const float pb = __expf(mb - ma), inv = 1.f / (1.f + pb);
                w0 = gprob * inv; w1 = gprob * pb * inv; e0 = gi * 8 + ia; e1 = gi * 8 + ib; rstd_t = rstd;
                ea[wid * 16 + lane] = e0; eb[wid * 16 + lane] = e1;
            }
        }
        __syncthreads();
        if (wid < 4 && lane < 16) {
            const int t = wid * 16 + lane; int s0 = 0, s1 = 0;
            for (int q = 0; q < t; ++q) { const int qa = ea[q], qb = eb[q]; s0 += (qa == e0) + (qb == e0); s1 += (qa == e1) + (qb == e1); }
            TOKR[unit * 64 + t] = (u32x4){(unsigned)(e0 | (e1 << 8) | (s0 << 16) | (s1 << 24)), __float_as_uint(w0), __float_as_uint(w1), __float_as_uint(rstd_t)};
        }
        if (tid >= 256 && tid < 256 + NEXP) { const int e = tid - 256; unsigned c = 0; for (int q = 0; q < 64; ++q) c += (ea[q] == e) + (eb[q] == e); WH[unit * NEXP + e] = c; }
        __syncthreads();
    }
}

DEVI int build_tiles(const unsigned* cnt, int* tstart) {
    if (threadIdx.x == 0) { int acc = 0; for (int e = 0; e < NEXP; ++e) { tstart[e] = acc; acc += (int)((cnt[e] + 255u) >> 8); } tstart[NEXP] = acc; }
    __syncthreads();
    return tstart[NEXP];
}
DEVI void phase_gather(const Args& a, int layer, unsigned char* lds) {
    const unsigned* WH = (const unsigned*)(a.ws + WS_WH);
    const u32x4* TOKR = (const u32x4*)(a.ws + WS_TOKR);
    unsigned* CNT = (unsigned*)(a.ws + WS_CNT) + layer * 64;
    const bf16_t* XB = (const bf16_t*)(a.ws + WS_XB); bf16_t* XG = (bf16_t*)(a.ws + WS_XG); u32x4* RI = (u32x4*)(a.ws + WS_RI);
    int* tstart = (int*)lds;
    unsigned* cntl = (unsigned*)(lds + 256);
    unsigned* basel = cntl + 32;
    const int tid = threadIdx.x, wid = tid >> 6, lane = tid & 63;
    for (int unit = blockIdx.x; unit < T_TOK / 64; unit += gridDim.x) {
        if (tid < NEXP) { unsigned tot = 0, bs = 0; for (int u = 0; u < T_TOK / 64; ++u) { const unsigned c = WH[u * NEXP + tid]; bs += (u < unit) ? c : 0u; tot += c; }
            cntl[tid] = tot; basel[tid] = bs; if (unit == 0) CNT[tid] = tot; }
        __syncthreads();
        build_tiles(cntl, tstart);
        for (int i = 0; i < 8; ++i) {
            const int tok = unit * 64 + wid * 8 + i;
            const u32x4 tr = TOKR[tok];
            const u32x4* src = (const u32x4*)(XB + (size_t)tok * DM); const u32x4 v0 = src[lane], v1 = src[64 + lane];
#pragma unroll
            for (int k = 0; k < 2; ++k) {
                const int e = (tr.x >> (8 * k)) & 0xff, sk = (tr.x >> (16 + 8 * k)) & 0xff;
                const size_t row = (size_t)tstart[e] * 256 + basel[e] + sk;
                u32x4* dst = (u32x4*)(XG + row * DM); dst[lane] = v0; dst[64 + lane] = v1;
                if (lane == 0) RI[row] = (u32x4){(unsigned)(tok * 2 + k), k ? tr.z : tr.y, tr.w, 0u};
            }
        }
        if (unit < NEXP) {
            const int e = unit; const size_t r0 = (size_t)tstart[e] * 256 + cntl[e], r1 = (size_t)tstart[e + 1] * 256;
            for (size_t row = r0 + wid; row < r1; row += NWAVES) {
                u32x4* dst = (u32x4*)(XG + row * DM); dst[lane] = (u32x4){0u, 0u, 0u, 0u}; dst[64 + lane] = (u32x4){0u, 0u, 0u, 0u};
                if (lane == 0) RI[row] = (u32x4){0xffffffffu, 0u, 0u, 0u};
            }
        }
        __syncthreads();
    }
}
DEVI void phase_moe1(const Args& a, int layer, unsigned char* lds) {
    const unsigned* cnt = (const unsigned*)(a.ws + WS_CNT) + layer * 64;
    int* tstart = (int*)lds; const int NT = build_tiles(cnt, tstart);
    SchedMoE S{(const bf16_t*)(a.ws + WS_XG), (const bf16_t*)(a.ws + WS_W1) + (size_t)layer * NEXP * 1024 * 1024, tstart, 1024, 1024, NT, (int)gridDim.x, (int)blockIdx.x};
    EpiSwiGLU E{(const u32x4*)(a.ws + WS_RI), (bf16_t*)(a.ws + WS_H)};
    gemm_phase_naive(GemmDesc{1024, 1024, 1024}, S, E);
}
DEVI void phase_moe2(const Args& a, int layer, unsigned char* lds) {
    const unsigned* cnt = (const unsigned*)(a.ws + WS_CNT) + layer * 64;
    int* tstart = (int*)lds; const int NT = build_tiles(cnt, tstart);
    SchedMoE S{(const bf16_t*)(a.ws + WS_H), (const bf16_t*)(a.ws + WS_W2) + (size_t)layer * NEXP * 1024 * 512, tstart, 512, 512, NT, (int)gridDim.x, (int)blockIdx.x};
    EpiMoeDown E{(const u32x4*)(a.ws + WS_RI), (bf16_t*)(a.ws + WS_Y)};
#ifdef PROBE_VALU6
    { Unit u; const u32x4* RI = (const u32x4*)(a.ws + WS_RI); bf16_t* Y = (bf16_t*)(a.ws + WS_Y);
      for (int i = 0; S.next(i, u); ++i) {
        for (int it = threadIdx.x; it < 256 * 32; it += NTHREADS) {
            const int r = it >> 5, cg = (it & 31) * 8;
            const bf16_t* hrow = u.A + (size_t)r * 512; const bf16_t* wrow = u.B + (size_t)cg * 512;
            float acc[8] = {0.f, 0.f, 0.f, 0.f, 0.f, 0.f, 0.f, 0.f};
            for (int k = 0; k < 512; ++k) { const float h = bf2f(hrow[k]);
#pragma unroll
                for (int jj = 0; jj < 8; ++jj) acc[jj] += h * bf2f(wrow[(size_t)jj * 512 + k]); }
            const size_t row = (size_t)u.pm * 256 + r; const u32x4 ri = RI[row]; const int dest = (int)ri.x; const float w = __uint_as_float(ri.y);
            if (dest >= 0) { u32x4 o; o.x = cvt_pk(acc[0] * w, acc[1] * w); o.y = cvt_pk(acc[2] * w, acc[3] * w); o.z = cvt_pk(acc[4] * w, acc[5] * w); o.w = cvt_pk(acc[6] * w, acc[7] * w);
                *(u32x4*)(Y + ((size_t)(dest & 1) * T_TOK + (size_t)(dest >> 1)) * DM + u.pn * 256 + cg) = o; }
        }
      } }
#else
    gemm_phase_naive(GemmDesc{512, 512, 512}, S, E);
#endif
}
template <bool FINAL>
DEVI void phase_resid(const Args& a) {
    float* X = (float*)(a.ws + WS_X); const bf16_t* Y = (const bf16_t*)(a.ws + WS_Y); bf16_t* XB = (bf16_t*)(a.ws + WS_XB); float* RS2 = (float*)(a.ws + WS_RS2);
    const int wid = threadIdx.x >> 6, lane = threadIdx.x & 63;
    for (int row = blockIdx.x * NWAVES + wid; row < T_TOK; row += gridDim.x * NWAVES) {
        f32x4 v[4]; float s = 0.f;
#pragma unroll
        for (int j = 0; j < 4; ++j) {
            const size_t off = (size_t)row * DM + 256 * j + 4 * lane;
            v[j] = *(const f32x4*)(X + off);
            const u32x2 y0 = *(const u32x2*)(Y + off), y1 = *(const u32x2*)(Y + (size_t)T_TOK * DM + off);
#if PROBE_LAST >= 6
            v[j][0] += bflo(y0.x) + bflo(y1.x); v[j][1] += bfhi(y0.x) + bfhi(y1.x); v[j][2] += bflo(y0.y) + bflo(y1.y); v[j][3] += bfhi(y0.y) + bfhi(y1.y);
#endif
            s += (v[j][0] * v[j][0] + v[j][1] * v[j][1]) + (v[j][2] * v[j][2] + v[j][3] * v[j][3]);
        }
        const float rstd = rsqrtf(wave_sum(s) * (1.f / DM) + EPS);
#pragma unroll
        for (int j = 0; j < 4; ++j) {
            const size_t off = (size_t)row * DM + 256 * j + 4 * lane;
#ifdef PROBE_H
            if (FINAL) { const u32x4* RIp = (const u32x4*)(a.ws + WS_RI); const u32x4 r0 = RIp[row], r1 = RIp[row + 16384], r2 = RIp[32768 + (row & 2047)];
                const float f = 1.f + 1e-4f * (float)(int)r0.x + __uint_as_float(r0.y) + 3e-4f * (float)(int)r1.x + 2.f * __uint_as_float(r1.y) + 7e-4f * (float)(int)r2.x + 3.f * __uint_as_float(r2.y) + __uint_as_float(r0.z) + __uint_as_float(r1.z) + __uint_as_float(r2.z);
                const f32x4 g = *(const f32x4*)(a.in[23] + 256 * j + 4 * lane); *(f32x4*)(a.out + off) = v[j] * rstd * g * f; }
#elif defined(PROBE_TOKR)
            if (FINAL) { const u32x4 tr = ((const u32x4*)(a.ws + WS_TOKR))[row]; const float f = 1.f + __uint_as_float(tr.y) + 3.f * __uint_as_float(tr.z) + 0.01f * (float)(tr.x & 0xff) + 0.02f * (float)((tr.x >> 8) & 0xff) + 0.001f * (float)((tr.x >> 16) & 0xff) + 0.002f * (float)(tr.x >> 24) + __uint_as_float(tr.w);
                const f32x4 g = *(const f32x4*)(a.in[23] + 256 * j + 4 * lane); *(f32x4*)(a.out + off) = v[j] * rstd * g * f; }
#else
            if (FINAL) { const f32x4 g = *(const f32x4*)(a.in[23] + 256 * j + 4 * lane); *(f32x4*)(a.out + off) = v[j] * rstd * g; }
#endif
            else { *(f32x4*)(X + off) = v[j]; u32x2 w; w.x = cvt_pk(v[j][0], v[j][1]); w.y = cvt_pk(v[j][2], v[j][3]); *(u32x2*)(XB + off) = w; }
        }
        if (!FINAL && lane == 0) RS2[row] = rstd;
    }
}

DEVI void phase_attn_naive(const Args& a, unsigned char* lds) {
    const bf16_t* Q = (const bf16_t*)(a.ws + WS_Q); const bf16_t* KN = (const bf16_t*)(a.ws + WS_KN); const bf16_t* KR = (const bf16_t*)(a.ws + WS_KR);
    const bf16_t* V = (const bf16_t*)(a.ws + WS_V); bf16_t* O = (bf16_t*)(a.ws + WS_O);
    const int wid = threadIdx.x >> 6, lane = threadIdx.x & 63;
    float* qs = (float*)lds + wid * DQK;
    for (int unit = blockIdx.x; unit < 2 * NH * (SEQ / 8); unit += gridDim.x) {
        const int bh = unit >> 10, s = (unit & 1023) * 8 + wid, b = bh >> 3, h = bh & 7;
        const bf16_t* qp = Q + ((size_t)bh * SEQ + s) * DQK;
        for (int i = lane; i < DQK; i += 64) qs[i] = bf2f(qp[i]);
        asm volatile("s_waitcnt lgkmcnt(0)" ::: "memory");
        const int nt = (s >> 6) + 1; float m = -1e30f, l = 0.f, o0 = 0.f, o1 = 0.f;
        for (int jt = 0; jt < nt; ++jt) {
            const int key = jt * 64 + lane;
            const bf16_t* kn = KN + ((size_t)bh * SEQ + key) * DNOPE; const bf16_t* kr = KR + ((size_t)b * SEQ + key) * DROPE;
            float sc = 0.f;
            for (int d = 0; d < DNOPE; d += 8) { const u32x4 kv = *(const u32x4*)(kn + d); const f32x4 q0 = *(const f32x4*)(qs + d), q1 = *(const f32x4*)(qs + d + 4);
                sc += q0[0] * bflo(kv.x) + q0[1] * bfhi(kv.x) + q0[2] * bflo(kv.y) + q0[3] * bfhi(kv.y) + q1[0] * bflo(kv.z) + q1[1] * bfhi(kv.z) + q1[2] * bflo(kv.w) + q1[3] * bfhi(kv.w); }
            for (int d = 0; d < DROPE; d += 8) { const u32x4 kv = *(const u32x4*)(kr + d); const f32x4 q0 = *(const f32x4*)(qs + DNOPE + d), q1 = *(const f32x4*)(qs + DNOPE + d + 4);
                sc += q0[0] * bflo(kv.x) + q0[1] * bfhi(kv.x) + q0[2] * bflo(kv.y) + q0[3] * bfhi(kv.y) + q1[0] * bflo(kv.z) + q1[1] * bfhi(kv.z) + q1[2] * bflo(kv.w) + q1[3] * bfhi(kv.w); }
            const float mn = fmaxf(m, wave_max(sc)), alpha = __builtin_amdgcn_exp2f(m - mn), p = __builtin_amdgcn_exp2f(sc - mn);
            l = l * alpha + wave_sum(p); o0 *= alpha; o1 *= alpha; m = mn;
            const bf16_t* vp = V + ((size_t)bh * SEQ + jt * 64) * DV + 2 * lane;
            for (int j = 0; j < 64; ++j) { const float pj = __shfl(p, j); const unsigned vv = *(const unsigned*)(vp + j * DV); o0 += pj * bflo(vv); o1 += pj * bfhi(vv); }
        }
        const float il = 1.f / l;
        *(unsigned*)(O + ((size_t)b * SEQ + s) * DM + h * DV + 2 * lane) = cvt_pk(o0 * il, o1 * il);
        asm volatile("s_waitcnt lgkmcnt(0)" ::: "memory");
    }
}

#define XB_TMO      128
#define XB_XCNT(j)  (256  + 64 * (j))
#define XB_XSUB(j)  (1280 + 64 * (j))
#define XB_XGEN(j)  (2304 + 64 * (j))
#define XB_TOP      3328
#define XB_TOPGEN   3392
#define XCD_BAR_WORDS 3456
#define XB_SPIN_CAP (1u << 18)
#define LAS __attribute__((address_space(3)))
__device__ __forceinline__ unsigned xb_ld(unsigned* p)              { return __hip_atomic_load(p, __ATOMIC_RELAXED, __HIP_MEMORY_SCOPE_AGENT); }
__device__ __forceinline__ unsigned xb_add(unsigned* p, unsigned v) { return __hip_atomic_fetch_add(p, v, __ATOMIC_RELAXED, __HIP_MEMORY_SCOPE_AGENT); }
__device__ __forceinline__ unsigned xb_xcc_id() { return (unsigned)__builtin_amdgcn_s_getreg((3 << 11) | 20) & 0xFu; }
#define XB_SPIN(cond, bar) do { unsigned _sp = 0; while (cond) { __builtin_amdgcn_s_sleep(1); \
    if ((++_sp & 255u) == 0u) { if (xb_ld(&(bar)[XB_TMO])) break; if (_sp > XB_SPIN_CAP) { atomicAdd(&(bar)[XB_TMO], 1u); break; } } } } while (0)
struct XcdBarrier { unsigned* bar; unsigned x; volatile LAS unsigned* st; };
__device__ __forceinline__ XcdBarrier xcd_barrier_post(unsigned* bar, volatile LAS unsigned* st) {
    XcdBarrier b; b.bar = bar; b.x = xb_xcc_id(); b.st = st;
    if (threadIdx.x == 0) (void)xb_add(&bar[XB_XCNT(b.x)], 1u);
    return b;
}
__device__ __forceinline__ void xcd_barrier_complete(unsigned* bar, unsigned x, unsigned& nloc, unsigned& nx) {
    const unsigned G = gridDim.x * gridDim.y * gridDim.z;
    unsigned sum, cnt, mine, sp = 0u;
    for (;;) {
        sum = 0u; cnt = 0u; mine = 0u;
#pragma unroll
        for (unsigned j = 0; j < 16; ++j) { const unsigned c = xb_ld(&bar[XB_XCNT(j)]); sum += c; cnt += (c > 0u) ? 1u : 0u; mine = (j == x) ? c : mine; }
        if (sum == G) break;
        __builtin_amdgcn_s_sleep(1);
        if ((++sp & 255u) == 0u) { if (xb_ld(&bar[XB_TMO])) break; if (sp > XB_SPIN_CAP) { atomicAdd(&bar[XB_TMO], 1u); break; } }
    }
    nloc = mine > 0u ? mine : 1u; nx = cnt > 0u ? cnt : 1u;
}
__device__ __forceinline__ void xcd_barrier(const XcdBarrier& b) {
    asm volatile("s_waitcnt vmcnt(0)" ::: "memory");
    __syncthreads();
    if (threadIdx.x == 0) {
        unsigned* bar = b.bar;
        __builtin_amdgcn_s_waitcnt(0);
        unsigned nloc = b.st[0], nx = b.st[1];
        if (nloc == 0u) { xcd_barrier_complete(bar, b.x, nloc, nx); b.st[0] = nloc; b.st[1] = nx; }
        const unsigned old = xb_add(&bar[XB_XSUB(b.x)], 1u);
        const unsigned gen = old / nloc;
        if (old + 1u == (gen + 1u) * nloc) {
            __builtin_amdgcn_fence(__ATOMIC_RELEASE, "agent");
            asm volatile("s_waitcnt vmcnt(0)" ::: "memory");
            const unsigned og = xb_add(&bar[XB_TOP], 1u);
            const unsigned tg = og / nx;
            if (og + 1u == (tg + 1u) * nx) xb_add(&bar[XB_TOPGEN], 1u);
            else XB_SPIN(xb_ld(&bar[XB_TOPGEN]) == tg, bar);
            __builtin_amdgcn_fence(__ATOMIC_ACQUIRE, "agent");
            xb_add(&bar[XB_XGEN(b.x)], 1u);
            asm volatile("s_waitcnt vmcnt(0)" ::: "memory");
        } else {
            XB_SPIN(xb_ld(&bar[XB_XGEN(b.x)]) == gen, bar);
            __builtin_amdgcn_fence(__ATOMIC_ACQUIRE, "agent");
            asm volatile("s_waitcnt vmcnt(0)" ::: "memory");
        }
    }
    __syncthreads();
}

constexpr int NPHASES = 17;
__global__ void __launch_bounds__(NTHREADS, 2) fwd(Args a) {
    extern __shared__ __attribute__((aligned(16))) unsigned char lds[];
    unsigned char* ws = a.ws;
    const int lo = a.ph_lo, hi = a.ph_hi, G = gridDim.x, c = blockIdx.x;
    volatile LAS unsigned* misc = (volatile LAS unsigned*)((LAS unsigned char*)lds + MISC_OFF);
    if (threadIdx.x < 16) misc[threadIdx.x] = 0u;
    __syncthreads();
    XcdBarrier bar; bar.bar = (unsigned*)(ws + WS_CTL) + CW_BAR; bar.x = 0; bar.st = misc;
    if (hi - lo > 1) bar = xcd_barrier_post((unsigned*)(ws + WS_CTL) + CW_BAR, misc);
#define IN(k) (lo <= (k) && (k) < hi)
#define SEAM(k) do { if (IN(k) && IN((k) + 1)) xcd_barrier(bar); } while (0)
    if (IN(0)) phase_prologue(a, lds);
    SEAM(0);
    if (IN(1)) phase_pool_prep(a, lds);
    SEAM(1);
    if (IN(2)) {
        SchedDense S{(const bf16_t*)(ws + WS_PB), (const bf16_t*)(ws + WS_WPOOL), 1024, 64, 4, G, c, 256, 65536};
        EpiPool E{a.in[0], (const float*)(ws + WS_PBIAS), (float*)(ws + WS_X), (bf16_t*)(ws + WS_XB)};
        gemm_phase_naive(GemmDesc{1024, 256, 256}, S, E);
    }
    SEAM(2);
    if (IN(3)) phase_route(a, 0, lds);
    SEAM(3);
    if (IN(4)) phase_gather(a, 0, lds);
    SEAM(4);
    if (IN(5)) phase_moe1(a, 0, lds);
    SEAM(5);
    if (IN(6)) phase_moe2(a, 0, lds);
    SEAM(6);
    if (IN(7)) phase_resid<false>(a);
    SEAM(7);
    if (IN(8)) {
        SchedDense S{(const bf16_t*)(ws + WS_XB), (const bf16_t*)(ws + WS_WDOWN), 1024, 64, 3, G, c, 0, (size_t)256 * 1024};
        const float* rc = (const float*)(ws + WS_ROPE);
        EpiDownProj E{(const float*)(ws + WS_RS2), (bf16_t*)(ws + WS_CKV), (bf16_t*)(ws + WS_CQ), (bf16_t*)(ws + WS_KR), (float*)(ws + WS_SSKV), (float*)(ws + WS_SSQ), rc, rc + SEQ * 32};
        gemm_phase_naive(GemmDesc{1024, 1024, 1024}, S, E);
    }
    SEAM(8);
    if (IN(9)) {
        { SchedDense S{(const bf16_t*)(ws + WS_CKV), (const bf16_t*)(ws + WS_WUPKV), 256, 64, 8, G, c, 0, (size_t)256 * 256};
          EpiUpKV E{(const float*)(ws + WS_SSKV), (bf16_t*)(ws + WS_KN), (bf16_t*)(ws + WS_V)};
          gemm_phase_naive(GemmDesc{256, 256, 256}, S, E); }
        { SchedDense S{(const bf16_t*)(ws + WS_CQ), (const bf16_t*)(ws + WS_WUPQ), 384, 64, 6, G, c, 0, (size_t)256 * 384};
          const float* rc = (const float*)(ws + WS_ROPE);
          EpiUpQ E{(const float*)(ws + WS_SSQ), (bf16_t*)(ws + WS_Q), rc, rc + SEQ * 32};
          gemm_phase_naive(GemmDesc{384, 384, 384}, S, E); }
    }
    SEAM(9);
    if (IN(10)) phase_attn_naive(a, lds);
    SEAM(10);
    if (IN(11)) {
        SchedDense S{(const bf16_t*)(ws + WS_O), (const bf16_t*)(ws + WS_WO), 1024, 64, 4, G, c, 0, (size_t)256 * 1024};
        EpiWo E{(float*)(ws + WS_X), (bf16_t*)(ws + WS_XB)};
        gemm_phase_naive(GemmDesc{1024, 1024, 1024}, S, E);
    }
    SEAM(11);
    if (IN(12)) phase_route(a, 1, lds);
    SEAM(12);
    if (IN(13)) phase_gather(a, 1, lds);
    SEAM(13);
    if (IN(14)) phase_moe1(a, 1, lds);
    SEAM(14);
    if (IN(15)) phase_moe2(a, 1, lds);
    SEAM(15);
    if (IN(16)) phase_resid<true>(a);
#undef IN
#undef SEAM
}

extern "C" void kernel_launch(void* const* d_in, const int* in_sizes, int n_in, void* d_out, int out_size, void* d_ws, size_t ws_size, hipStream_t stream) {
    static int grid = 0;
    if (grid == 0) {
        if (n_in != 24 || ws_size < WS_END) { fprintf(stderr, "kernel_launch: unexpected n_in %d / ws_size %zu\n", n_in, ws_size); grid = -1; return; }
        int dev = 0, cus = 0;
        if (hipGetDevice(&dev) != hipSuccess || hipDeviceGetAttribute(&cus, hipDeviceAttributeMultiprocessorCount, dev) != hipSuccess || cus <= 0) cus = 256;
        if (hipFuncSetAttribute((const void*)fwd, hipFuncAttributeMaxDynamicSharedMemorySize, LDS_BYTES) != hipSuccess) { fprintf(stderr, "hipFuncSetAttribute failed\n"); grid = -1; return; }
        grid = cus;
    }
    if (grid < 0) return;
    (void)hipMemsetAsync((char*)d_ws + WS_CTL, 0, CTL_ZERO_BYTES, stream);
    Args a{};
    for (int i = 0; i < 24; ++i) a.in[i] = (const float*)d_in[i];
    a.out = (float*)d_out; a.ws = (unsigned char*)d_ws;
#ifndef PROBE_LAST
#define PROBE_LAST 15
#endif
    a.ph_lo = 0; a.ph_hi = NPHASES; a.li = 0; a.pad = 0;
    hipLaunchKernelGGL(fwd, dim3(grid), dim3(NTHREADS), LDS_BYTES, stream, a);
}
```

```cpp
#include <hip/hip_runtime.h>
#include <stdint.h>
#include <stdio.h>
#define NAIVE_MASK 0x0u

#define DEVI __device__ __forceinline__
#define LAS __attribute__((address_space(3)))
typedef unsigned short bf16_t;
typedef short bf16x8 __attribute__((ext_vector_type(8)));
typedef float f32x4 __attribute__((ext_vector_type(4)));
typedef float f32x2 __attribute__((ext_vector_type(2)));
typedef unsigned u32x4 __attribute__((ext_vector_type(4)));
typedef unsigned u32x2 __attribute__((ext_vector_type(2)));

constexpr int T_TOK = 16384, SEQ = 8192, DM = 1024;
constexpr int NEXP = 32, DEXP = 512;
constexpr int NH = 8, DQK = 192, DNOPE = 128, DROPE = 64, DV = 128, QRANK = 384, KVRANK = 256;
constexpr float EPS = 1e-6f;
constexpr float QSCALE = 0.10411754627697266f;
constexpr int NWAVES = 8, NTHREADS = 512;
constexpr int LDS_BYTES = 147456, MISC_OFF = 147456 - 64, TS_OFF = 131072;

constexpr size_t MiB = 1u << 20;
constexpr size_t WS_CTL = 0, CTL_ZERO_BYTES = 65536;
constexpr size_t WS_WPOOL = 1 * MiB, WS_WDOWN = 2 * MiB, WS_WUPKV = 4 * MiB, WS_WUPQ = 5 * MiB, WS_WO = 7 * MiB;
constexpr size_t WS_WR = 9 * MiB;
constexpr size_t WS_PBIAS = 9 * MiB + 512 * 1024;
constexpr size_t WS_ROPE = 10 * MiB;
constexpr size_t WS_WH = 12 * MiB;
constexpr size_t WS_CNT = 12 * MiB + 64 * 1024;
constexpr size_t WS_TOKR = 13 * MiB;
constexpr size_t WS_W1 = 16 * MiB, WS_W2 = 144 * MiB;
constexpr size_t WS_X = 208 * MiB, WS_XB = 272 * MiB;
constexpr size_t WS_XG = 304 * MiB, WS_H = 384 * MiB, WS_Y = 424 * MiB;
constexpr size_t WS_PB = 304 * MiB;
constexpr size_t WS_Q = 304 * MiB, WS_KN = 352 * MiB, WS_V = 384 * MiB, WS_O = 416 * MiB;
constexpr size_t WS_CKV = 448 * MiB, WS_CQ = 456 * MiB, WS_KR = 468 * MiB;
constexpr size_t WS_RI = 488 * MiB;
constexpr size_t WS_RS = 489 * MiB;
constexpr size_t WS_RS2 = 489 * MiB + 64 * 1024;
constexpr size_t WS_SSKV = 490 * MiB;
constexpr size_t WS_SSQ = 490 * MiB + 256 * 1024;
constexpr size_t WS_END = 492 * MiB;
constexpr int MAXTILES = 160;

constexpr int CW_CNT = 1024;
constexpr int CW_BAR = 4096;

struct Args { const float* in[24]; float* out; unsigned char* ws; int ph_lo, ph_hi, li, pad; };

typedef __bf16 bf16x2_t __attribute__((ext_vector_type(2)));
DEVI unsigned cvt_pk(float lo, float hi) { const f32x2 v = {lo, hi}; return __builtin_bit_cast(unsigned, __builtin_convertvector(v, bf16x2_t)); }
DEVI float bf2f(unsigned short b) { return __uint_as_float((unsigned)b << 16); }
DEVI float bflo(unsigned w) { return __uint_as_float(w << 16); }
DEVI float bfhi(unsigned w) { return __uint_as_float(w & 0xffff0000u); }
DEVI float wave_sum(float v) {
#pragma unroll
    for (int o = 1; o < 64; o <<= 1) v += __shfl_xor(v, o);
    return v;
}
DEVI float wave_max(float v) {
#pragma unroll
    for (int o = 1; o < 64; o <<= 1) v = fmaxf(v, __shfl_xor(v, o));
    return v;
}
DEVI u32x4 pack8(f32x4 a, f32x4 b) { u32x4 w; w.x = cvt_pk(a[0], a[1]); w.y = cvt_pk(a[2], a[3]); w.z = cvt_pk(b[0], b[1]); w.w = cvt_pk(b[2], b[3]); return w; }

struct Unit { const bf16_t* A; const bf16_t* B; int pm, pn; };
struct GemmDesc { int lda, ldb, K; };

struct SchedDense {
    const bf16_t* A; const bf16_t* B; int lda, nM, nN, G, c; size_t a_pn_off, b_pn_off;
    DEVI bool next(int i, Unit& u) const {
        const int L = i * G + c; if (L >= nM * nN) return false;
        u.pm = L / nN; u.pn = L - u.pm * nN;
        u.A = A + (size_t)u.pm * 256 * lda + (size_t)u.pn * a_pn_off; u.B = B + (size_t)u.pn * b_pn_off; return true;
    }
};
struct SchedMoE {
    const bf16_t* A; const bf16_t* W; const int* tstart; int lda, ldb, NT, G, c;
    DEVI bool next(int i, Unit& u) const {
        const int L = i * G + c; if (L >= NT * 4) return false;
        u.pm = L >> 2; u.pn = L & 3; int e = 0;
        for (int k = 1; k < NEXP; ++k) e += (tstart[k] <= u.pm) ? 1 : 0;
        u.A = A + (size_t)u.pm * 256 * lda; u.B = W + ((size_t)e * 1024 + (size_t)u.pn * 256) * ldb; return true;
    }
};

template <class Epi, class Sched>
DEVI void gemm_phase_naive(const GemmDesc g, const Sched& S, const Epi& E) {
    const int tid = threadIdx.x, wid = __builtin_amdgcn_readfirstlane(tid >> 6), lane = tid & 63, wr = wid >> 2, wc = wid & 3, fr = lane & 15, fq = lane >> 4;
    Unit u;
    for (int i = 0; S.next(i, u); ++i) {
        f32x4 acc[2][2][4][2];
#pragma unroll
        for (int a = 0; a < 2; ++a)
#pragma unroll
            for (int b = 0; b < 2; ++b)
#pragma unroll
                for (int m = 0; m < 4; ++m)
#pragma unroll
                    for (int n = 0; n < 2; ++n) acc[a][b][m][n] = (f32x4){0.f, 0.f, 0.f, 0.f};
        const bf16_t* a0 = u.A + (size_t)(wr * 64 + fr) * g.lda + fq * 8;
        const bf16_t* b0 = u.B + (size_t)(wc * 32 + 8 * (fr >> 2) + (fr & 3)) * g.ldb + fq * 8;
#pragma unroll 1
        for (int k = 0; k < g.K; k += 32) {
            bf16x8 av[2][4], bv[2][2];
#pragma unroll
            for (int ai = 0; ai < 2; ++ai)
#pragma unroll
                for (int m = 0; m < 4; ++m) av[ai][m] = *(const bf16x8*)(a0 + (size_t)(ai * 128 + m * 16) * g.lda + k);
#pragma unroll
            for (int bj = 0; bj < 2; ++bj)
#pragma unroll
                for (int n = 0; n < 2; ++n) bv[bj][n] = *(const bf16x8*)(b0 + (size_t)(bj * 128 + 4 * n) * g.ldb + k);
#pragma unroll
            for (int ai = 0; ai < 2; ++ai)
#pragma unroll
                for (int bj = 0; bj < 2; ++bj)
#pragma unroll
                    for (int m = 0; m < 4; ++m)
#pragma unroll
                        for (int n = 0; n < 2; ++n) acc[ai][bj][m][n] = __builtin_amdgcn_mfma_f32_16x16x32_bf16(bv[bj][n], av[ai][m], acc[ai][bj][m][n], 0, 0, 0);
        }
        E(acc, u, wr, wc, fr, fq);
    }
}

namespace pg8 {
constexpr int BM = 256, BK = 64, HALF = 128, HTB = HALF * BK * 2, STAGE_BYTES = 8 * HTB;
__host__ __device__ __forceinline__ int lds_byte(int r, int c) { const int st = (r >> 4) * 2 + (c >> 5), rr = r & 15, cc = c & 31, ob = rr * 64 + cc * 2; return st * 1024 + (ob ^ (((ob >> 9) & 1) << 5)); }
__host__ __device__ __forceinline__ void stage_rc(int b, int& R, int& C) { const int st = b / 1024, sb = b % 1024, swz = sb ^ (((sb >> 9) & 1) << 5); R = (st >> 1) * 16 + swz / 64; C = (st & 1) * 32 + (swz % 64) / 2; }
__host__ __device__ __forceinline__ int perm32(int rho) { const int n = rho >> 4, i = rho & 15; return 8 * (i >> 2) + 4 * n + (i & 3); }

template <class Epi, class Sched, bool ALIGN_EPI = true, bool SP2 = true>
__device__ __forceinline__ void gemm_phase(LAS unsigned char* lds, const GemmDesc g, const Sched& S, const Epi& E) {
    const int tid = threadIdx.x, wid = __builtin_amdgcn_readfirstlane(tid >> 6), lane = tid & 63, wr = wid >> 2, wc = wid & 3, fr = lane & 15, fq = lane >> 4;
    int K = g.K; asm volatile("" : "+s"(K));
    const int nt = K / BK;
    unsigned voffA[2], voffB[2];
#pragma unroll
    for (int i = 0; i < 2; ++i) { int R, C; stage_rc(tid * 16 + i * 8192, R, C); const int Rb = (R & ~31) + perm32(R & 31);
        voffA[i] = (unsigned)(R * g.lda + C) * 2u; voffB[i] = (unsigned)(Rb * g.ldb + C) * 2u; }
    const size_t kstep = (size_t)(BK * 2);
    const size_t hstepA = (size_t)HALF * g.lda * 2, hstepB = (size_t)HALF * g.ldb * 2;
    const unsigned ldsw = (unsigned)wid * 1024u;
    const int aoff = lds_byte(wr * 64 + fr, fq * 8), boff = lds_byte(wc * 32 + fr, fq * 8);
#define PG8_SA(b, h) (((b) * 2 + (h)) * HTB)
#define PG8_SB(b, h) ((4 + (b) * 2 + (h)) * HTB)
#define PG8_STAGE(bufoff, gbase, voff) do { _Pragma("unroll") for (int _i = 0; _i < 2; ++_i) \
        __builtin_amdgcn_global_load_lds((const unsigned*)((const char*)(gbase) + (voff)[_i]), (LAS unsigned*)(lds + (bufoff) + ldsw + _i * 8192), 16, 0, 0); } while (0)
#define PG8_LDA(dst, b, h) do { _Pragma("unroll") for (int m = 0; m < 4; ++m) _Pragma("unroll") for (int k = 0; k < 2; ++k) dst[m][k] = *(const LAS bf16x8*)(lds + PG8_SA(b, h) + aoff + m * 2048 + k * 1024); } while (0)
#define PG8_LDB(dst, b, h) do { _Pragma("unroll") for (int n = 0; n < 2; ++n) _Pragma("unroll") for (int k = 0; k < 2; ++k) dst[n][k] = *(const LAS bf16x8*)(lds + PG8_SB(b, h) + boff + n * 2048 + k * 1024); } while (0)
#define PG8_MMA(ai, bj, At, Bt) do { __builtin_amdgcn_s_setprio(1); _Pragma("unroll") for (int m = 0; m < 4; ++m) _Pragma("unroll") for (int n = 0; n < 2; ++n) _Pragma("unroll") for (int k = 0; k < 2; ++k) \
        acc[ai][bj][m][n] = __builtin_amdgcn_mfma_f32_16x16x32_bf16(Bt[n][k], At[m][k], acc[ai][bj][m][n], 0, 0, 0); __builtin_amdgcn_s_setprio(0); } while (0)
#define PG8_WAIT_V(n) asm volatile("s_waitcnt vmcnt(" #n ")" ::: "memory")
#define PG8_WAIT_L(n) asm volatile("s_waitcnt lgkmcnt(" #n ")" ::: "memory")
#define PG8_BAR __builtin_amdgcn_s_barrier()
#define PG8_SCHED __builtin_amdgcn_sched_barrier(0)
    Unit cur, nxt; int ui = 0;
    if (!S.next(0, cur)) return;
    f32x4 acc[2][2][4][2];
#pragma unroll
    for (int a = 0; a < 2; ++a)
#pragma unroll
        for (int b = 0; b < 2; ++b)
#pragma unroll
            for (int m = 0; m < 4; ++m)
#pragma unroll
                for (int n = 0; n < 2; ++n) acc[a][b][m][n] = (f32x4){0.f, 0.f, 0.f, 0.f};
    bf16x8 At[4][2], B0[2][2], B1[2][2];
    const char* cA = (const char*)cur.A; const char* cB = (const char*)cur.B;
    if constexpr (SP2) {
        PG8_STAGE(PG8_SB(0, 0), cB, voffB); PG8_STAGE(PG8_SB(0, 1), cB + hstepB, voffB); PG8_STAGE(PG8_SA(0, 0), cA, voffA); PG8_STAGE(PG8_SA(0, 1), cA + hstepA, voffA);
        if (wr == 1) PG8_BAR;
        PG8_WAIT_V(2); PG8_BAR;
        PG8_STAGE(PG8_SB(1, 0), cB + kstep, voffB); PG8_STAGE(PG8_SA(1, 0), cA + kstep, voffA); PG8_STAGE(PG8_SB(1, 1), cB + hstepB + kstep, voffB);
        PG8_WAIT_V(6); PG8_BAR;
    } else {
        PG8_STAGE(PG8_SB(0, 0), cB, voffB); PG8_STAGE(PG8_SA(0, 0), cA, voffA); PG8_STAGE(PG8_SB(0, 1), cB + hstepB, voffB); PG8_STAGE(PG8_SA(0, 1), cA + hstepA, voffA);
        if (wr == 1) PG8_BAR;
        PG8_WAIT_V(4); PG8_BAR;
        PG8_STAGE(PG8_SB(1, 0), cB + kstep, voffB); PG8_STAGE(PG8_SA(1, 0), cA + kstep, voffA); PG8_STAGE(PG8_SB(1, 1), cB + hstepB + kstep, voffB);
        PG8_WAIT_V(6); PG8_BAR;
    }
    for (;;) {
        const bool has_next = S.next(ui + 1, nxt);
        const char* nA = has_next ? (const char*)nxt.A : cA; const char* nB = has_next ? (const char*)nxt.B : cB;
        for (int t = 0; t < nt; t += 2) {
            const bool last = (t == nt - 2);
            const char* a1 = cA + (size_t)(t + 1) * kstep;
            const char* a2 = last ? nA : cA + (size_t)(t + 2) * kstep; const char* b2 = last ? nB : cB + (size_t)(t + 2) * kstep;
            const char* a3 = a2 + kstep; const char* b3 = b2 + kstep;
            if constexpr (SP2) {
            PG8_LDB(B0, 0, 0); PG8_LDB(B1, 0, 1); PG8_SCHED; PG8_LDA(At, 0, 0); PG8_STAGE(PG8_SA(1, 1), a1 + hstepA, voffA);
            PG8_WAIT_V(8); PG8_WAIT_L(0); PG8_BAR; PG8_MMA(0, 0, At, B0); PG8_MMA(0, 1, At, B1); PG8_BAR; PG8_SCHED;
            PG8_LDA(At, 0, 1); PG8_STAGE(PG8_SB(0, 0), b2, voffB); PG8_STAGE(PG8_SB(0, 1), b2 + hstepB, voffB); PG8_STAGE(PG8_SA(0, 0), a2, voffA);
            PG8_WAIT_V(8); PG8_WAIT_L(0); PG8_BAR; PG8_MMA(1, 0, At, B0); PG8_MMA(1, 1, At, B1); PG8_BAR; PG8_SCHED;
            PG8_LDB(B0, 1, 0); PG8_LDB(B1, 1, 1); PG8_SCHED; PG8_LDA(At, 1, 0); PG8_STAGE(PG8_SA(0, 1), a2 + hstepA, voffA);
            PG8_WAIT_V(8); PG8_WAIT_L(0); PG8_BAR; PG8_MMA(0, 0, At, B0); PG8_MMA(0, 1, At, B1); PG8_BAR; PG8_SCHED;
            PG8_LDA(At, 1, 1); PG8_STAGE(PG8_SB(1, 0), b3, voffB); PG8_STAGE(PG8_SB(1, 1), b3 + hstepB, voffB); PG8_STAGE(PG8_SA(1, 0), a3, voffA);
            PG8_WAIT_V(8); PG8_WAIT_L(0); PG8_BAR; PG8_MMA(1, 0, At, B0); PG8_MMA(1, 1, At, B1); PG8_BAR; PG8_SCHED;
            } else {
            PG8_LDB(B0, 0, 0); PG8_SCHED; PG8_LDA(At, 0, 0); PG8_STAGE(PG8_SA(1, 1), a1 + hstepA, voffA);
            PG8_WAIT_L(8); PG8_BAR; PG8_WAIT_L(0); PG8_MMA(0, 0, At, B0); PG8_BAR; PG8_SCHED;
            PG8_LDB(B1, 0, 1); PG8_STAGE(PG8_SB(0, 0), b2, voffB);
            PG8_BAR; PG8_WAIT_L(0); PG8_MMA(0, 1, At, B1); PG8_BAR;
            PG8_LDA(At, 0, 1); PG8_STAGE(PG8_SA(0, 0), a2, voffA);
            PG8_BAR; PG8_WAIT_L(0); PG8_MMA(1, 0, At, B0); PG8_BAR; PG8_SCHED;
            PG8_STAGE(PG8_SB(0, 1), b2 + hstepB, voffB);
            PG8_WAIT_V(6); PG8_BAR; PG8_MMA(1, 1, At, B1); PG8_BAR;
            PG8_LDB(B0, 1, 0); PG8_SCHED; PG8_LDA(At, 1, 0); PG8_STAGE(PG8_SA(0, 1), a2 + hstepA, voffA);
            PG8_WAIT_L(8); PG8_BAR; PG8_WAIT_L(0); PG8_MMA(0, 0, At, B0); PG8_BAR; PG8_SCHED;
            PG8_LDB(B1, 1, 1); PG8_STAGE(PG8_SB(1, 0), b3, voffB);
            PG8_BAR; PG8_WAIT_L(0); PG8_MMA(0, 1, At, B1); PG8_BAR;
            PG8_LDA(At, 1, 1); PG8_STAGE(PG8_SA(1, 0), a3, voffA);
            PG8_BAR; PG8_WAIT_L(0); PG8_MMA(1, 0, At, B0); PG8_BAR; PG8_SCHED;
            PG8_STAGE(PG8_SB(1, 1), b3 + hstepB, voffB);
            PG8_WAIT_V(6); PG8_BAR; PG8_MMA(1, 1, At, B1); PG8_BAR;
            }
        }
        if constexpr (ALIGN_EPI) { if (wr == 0) PG8_BAR; }
        E(acc, cur, wr, wc, fr, fq);
        if (!has_next) break;
#pragma unroll
        for (int a = 0; a < 2; ++a)
#pragma unroll
            for (int b = 0; b < 2; ++b)
#pragma unroll
                for (int m = 0; m < 4; ++m)
#pragma unroll
                    for (int n = 0; n < 2; ++n) acc[a][b][m][n] = (f32x4){0.f, 0.f, 0.f, 0.f};
        cur = nxt; cA = nA; cB = nB; ++ui;
        if constexpr (ALIGN_EPI) { if (wr == 1) PG8_BAR; }
    }
    PG8_WAIT_V(0);
    if constexpr (!ALIGN_EPI) { if (wr == 0) PG8_BAR; }
    PG8_BAR;
#undef PG8_SA
#undef PG8_SB
#undef PG8_STAGE
#undef PG8_LDA
#undef PG8_LDB
#undef PG8_MMA
#undef PG8_WAIT_V
#undef PG8_WAIT_L
#undef PG8_BAR
#undef PG8_SCHED
}
}

#ifndef NAIVE_MASK
#define NAIVE_MASK 0u
#endif
#define GEMM_PHASE(ph, g, S, E) do { if ((NAIVE_MASK >> (ph)) & 1u) gemm_phase_naive(g, S, E); else pg8::gemm_phase((LAS unsigned char*)lds, g, S, E); } while (0)
DEVI void opaque(unsigned& x) { asm volatile("" : "+v"(x)); }
#define EPI_ROWS_BEGIN(r0) { unsigned row_ = (r0); _Pragma("unroll") for (int ai = 0; ai < 2; ++ai) { _Pragma("unroll") for (int m = 0; m < 4; ++m) { opaque(row_); const unsigned row = row_;
#define EPI_ROWS_END row_ += 16u; } row_ += 64u; } }

struct EpiPool {
    const float* xin; const float* bias; float* X; bf16_t* XB;
    DEVI void operator()(const f32x4 (&acc)[2][2][4][2], const Unit& u, int wr, int wc, int fr, int fq) const {
        const unsigned col0 = u.pn * 256 + wc * 32 + 8 * fq;
        f32x4 bv[2][2];
#pragma unroll
        for (int bj = 0; bj < 2; ++bj) { bv[bj][0] = *(const f32x4*)(bias + col0 + bj * 128); bv[bj][1] = *(const f32x4*)(bias + col0 + bj * 128 + 4); }
        EPI_ROWS_BEGIN(u.pm * 256 + wr * 64 + fr)
            const unsigned off = row * DM + col0;
#pragma unroll
            for (int bj = 0; bj < 2; ++bj) {
                const unsigned o = off + bj * 128;
                const f32x4 x0 = *(const f32x4*)(xin + o), x1 = *(const f32x4*)(xin + o + 4);
                const f32x4 v0 = acc[ai][bj][m][0] + bv[bj][0] + x0, v1 = acc[ai][bj][m][1] + bv[bj][1] + x1;
                *(f32x4*)(X + o) = v0; *(f32x4*)(X + o + 4) = v1;
                *(u32x4*)(XB + o) = pack8(v0, v1);
            }
        EPI_ROWS_END
    }
};
struct EpiSwiGLU {
    const u32x4* RI; bf16_t* H;
    DEVI void operator()(const f32x4 (&acc)[2][2][4][2], const Unit& u, int wr, int wc, int fr, int fq) const {
        const unsigned col0 = (u.pn * 256 + wc * 32 + 8 * fq) >> 1;
        EPI_ROWS_BEGIN(u.pm * 256 + wr * 64 + fr)
            const float rstd = __uint_as_float(RI[row].z);
#pragma unroll
            for (int bj = 0; bj < 2; ++bj) {
                const f32x4 gv = acc[ai][bj][m][0] * rstd, uv = acc[ai][bj][m][1] * rstd;
                float h[4];
#pragma unroll
                for (int j = 0; j < 4; ++j) h[j] = gv[j] / (1.f + __expf(-gv[j])) * uv[j];
                u32x2 w; w.x = cvt_pk(h[0], h[1]); w.y = cvt_pk(h[2], h[3]);
                *(u32x2*)(H + row * DEXP + col0 + bj * 64) = w;
            }
        EPI_ROWS_END
    }
};
struct EpiMoeDown {
    const u32x4* RI; bf16_t* Y;
    DEVI void operator()(const f32x4 (&acc)[2][2][4][2], const Unit& u, int wr, int wc, int fr, int fq) const {
        const unsigned col0 = u.pn * 256 + wc * 32 + 8 * fq;
        EPI_ROWS_BEGIN(u.pm * 256 + wr * 64 + fr)
            const u32x4 ri = RI[row]; const int dest = (int)ri.x; const float w = __uint_as_float(ri.y);
            if (dest >= 0) {
                const unsigned o = ((unsigned)(dest & 1) * T_TOK + (unsigned)(dest >> 1)) * DM + col0;
#pragma unroll
                for (int bj = 0; bj < 2; ++bj) *(u32x4*)(Y + o + bj * 128) = pack8(acc[ai][bj][m][0] * w, acc[ai][bj][m][1] * w);
            }
        EPI_ROWS_END
    }
};
DEVI float sumsq8(f32x4 a, f32x4 b) { return ((a[0] * a[0] + a[1] * a[1]) + (a[2] * a[2] + a[3] * a[3])) + ((b[0] * b[0] + b[1] * b[1]) + (b[2] * b[2] + b[3] * b[3])); }
DEVI void rope4(f32x4 v0, f32x4 v1, f32x4 c, f32x4 s, u32x2& w1, u32x2& w2) {
    const float a1[4] = {v0[0], v0[2], v1[0], v1[2]}, a2[4] = {v0[1], v0[3], v1[1], v1[3]};
    float o1[4], o2[4];
#pragma unroll
    for (int j = 0; j < 4; ++j) { o1[j] = a1[j] * c[j] - a2[j] * s[j]; o2[j] = a2[j] * c[j] + a1[j] * s[j]; }
    w1.x = cvt_pk(o1[0], o1[1]); w1.y = cvt_pk(o1[2], o1[3]); w2.x = cvt_pk(o2[0], o2[1]); w2.y = cvt_pk(o2[2], o2[3]);
}
struct EpiDownProj {
    const float* RS2; bf16_t* CKV; bf16_t* CQ; bf16_t* KR; float* SSKV; float* SSQ; const float* ropec; const float* ropes;
    DEVI void operator()(const f32x4 (&acc)[2][2][4][2], const Unit& u, int wr, int wc, int fr, int fq) const {
        const unsigned colw = wc * 32 + 8 * fq;
        EPI_ROWS_BEGIN(u.pm * 256 + wr * 64 + fr)
            const float rstd = RS2[row];
            float ss = 0.f;
#pragma unroll
            for (int bj = 0; bj < 2; ++bj) {
                const unsigned col = bj * 128 + colw;
                const f32x4 v0 = acc[ai][bj][m][0] * rstd, v1 = acc[ai][bj][m][1] * rstd;
                if (u.pn == 0) { ss += sumsq8(v0, v1); *(u32x4*)(CKV + row * KVRANK + col) = pack8(v0, v1); }
                else if (u.pn == 1 && col < 64) {
                    const unsigned i0 = col >> 1, pos = row & (SEQ - 1);
                    const f32x4 c = *(const f32x4*)(ropec + pos * 32 + i0), s = *(const f32x4*)(ropes + pos * 32 + i0);
                    u32x2 w1, w2; rope4(v0, v1, c, s, w1, w2);
                    *(u32x2*)(KR + row * DROPE + i0) = w1; *(u32x2*)(KR + row * DROPE + 32 + i0) = w2;
                } else {
                    const unsigned cq = u.pn * 256 + col - 320;
                    if (cq < (unsigned)QRANK) { ss += sumsq8(v0, v1); *(u32x4*)(CQ + row * QRANK + cq) = pack8(v0, v1); }
                }
            }
            ss += __shfl_xor(ss, 16); ss += __shfl_xor(ss, 32);
            if (fq == 0) { if (u.pn == 0) SSKV[row * 4 + wc] = ss; else SSQ[row * 8 + (u.pn - 1) * 4 + wc] = ss; }
        EPI_ROWS_END
    }
};
struct EpiUpKV {
    const float* SSKV; bf16_t* KN; bf16_t* V;
    DEVI void operator()(const f32x4 (&acc)[2][2][4][2], const Unit& u, int wr, int wc, int fr, int fq) const {
        bf16_t* base = (u.pn < 4) ? KN : V;
        const unsigned h0 = (u.pn & 3) * 2, d = wc * 32 + 8 * fq;
        EPI_ROWS_BEGIN(u.pm * 256 + wr * 64 + fr)
            const f32x4 sp = *(const f32x4*)(SSKV + row * 4);
            const float rstd = rsqrtf(((sp[0] + sp[1]) + (sp[2] + sp[3])) * (1.f / KVRANK) + EPS);
            const unsigned b = row >> 13, s = row & (SEQ - 1);
#pragma unroll
            for (int bj = 0; bj < 2; ++bj)
                *(u32x4*)(base + (((b * NH + h0 + bj) * SEQ + s) * 128 + d)) = pack8(acc[ai][bj][m][0] * rstd, acc[ai][bj][m][1] * rstd);
        EPI_ROWS_END
    }
};
struct EpiUpQ {
    const float* SSQ; bf16_t* Q; const float* ropec; const float* ropes;
    DEVI void operator()(const f32x4 (&acc)[2][2][4][2], const Unit& u, int wr, int wc, int fr, int fq) const {
        unsigned hh[2], jj[2];
#pragma unroll
        for (int bj = 0; bj < 2; ++bj) { const unsigned n = u.pn * 256 + bj * 128 + wc * 32 + 8 * fq; hh[bj] = n / DQK; jj[bj] = n - hh[bj] * DQK; }
        EPI_ROWS_BEGIN(u.pm * 256 + wr * 64 + fr)
            const f32x4 sa = *(const f32x4*)(SSQ + row * 8), sb = *(const f32x4*)(SSQ + row * 8 + 4);
            const float rstd = rsqrtf((((sa[0] + sa[1]) + (sa[2] + sa[3])) + ((sb[0] + sb[1]) + (sb[2] + sb[3]))) * (1.f / QRANK) + EPS);
            const unsigned b = row >> 13, s = row & (SEQ - 1);
#pragma unroll
            for (int bj = 0; bj < 2; ++bj) {
                bf16_t* qrow = Q + ((b * NH + hh[bj]) * SEQ + s) * DQK;
                const f32x4 v0 = acc[ai][bj][m][0] * rstd, v1 = acc[ai][bj][m][1] * rstd;
                if (jj[bj] < (unsigned)DNOPE) { *(u32x4*)(qrow + jj[bj]) = pack8(v0, v1); }
                else {
                    const unsigned i0 = (jj[bj] - DNOPE) >> 1;
                    const f32x4 c = *(const f32x4*)(ropec + s * 32 + i0), sn = *(const f32x4*)(ropes + s * 32 + i0);
                    u32x2 w1, w2; rope4(v0, v1, c, sn, w1, w2);
                    *(u32x2*)(qrow + DNOPE + i0) = w1; *(u32x2*)(qrow + DNOPE + 32 + i0) = w2;
                }
            }
        EPI_ROWS_END
    }
};
struct EpiWo {
    float* X; bf16_t* XB;
    DEVI void operator()(const f32x4 (&acc)[2][2][4][2], const Unit& u, int wr, int wc, int fr, int fq) const {
        const unsigned col0 = u.pn * 256 + wc * 32 + 8 * fq;
        EPI_ROWS_BEGIN(u.pm * 256 + wr * 64 + fr)
            const unsigned off = row * DM + col0;
#pragma unroll
            for (int bj = 0; bj < 2; ++bj) {
                const unsigned o = off + bj * 128;
                const f32x4 v0 = *(const f32x4*)(X + o) + acc[ai][bj][m][0], v1 = *(const f32x4*)(X + o + 4) + acc[ai][bj][m][1];
                *(f32x4*)(X + o) = v0; *(f32x4*)(X + o + 4) = v1;
                *(u32x4*)(XB + o) = pack8(v0, v1);
            }
        EPI_ROWS_END
    }
};

struct ConvJob { const float* src; const float* gain; const float* cvec; bf16_t* dst; int ldsrc, lddst, k0, n0, width, map, mparam; float cscale; };
DEVI int dst_row(int map, int mparam, int n) {
    if (map == 0) return n + mparam;
    if (map == 1) return 8 * (n >> 2) + (n & 3) + mparam;
    if (map == 3) { const int p = n - 256; return 256 + 2 * (p & 31) + (p >> 5); }
    const int h = n / DQK, j = n - h * DQK; if (j < DNOPE) return n; const int p = j - DNOPE; return h * DQK + DNOPE + 2 * (p & 31) + (p >> 5);
}
constexpr int NCONV_EXP = 64 * 96, NCONV_SMALL = 212, NCONV = NCONV_EXP + NCONV_SMALL;
DEVI void conv_decode(const Args& a, int t, ConvJob& j) {
    unsigned char* ws = a.ws;
    j.gain = nullptr; j.cvec = nullptr; j.cscale = 1.f; j.width = 256; j.map = 0; j.mparam = 0;
    if (t < NCONV_EXP) {
        const int le = t / 96, r = t - le * 96, l = le >> 5;
        if (r < 64) { const int rr = r & 31, up = r >> 5; j.src = a.in[up ? 21 : 20] + (size_t)le * 1024 * 512; j.ldsrc = 512; j.k0 = (rr >> 1) * 64; j.n0 = (rr & 1) * 256;
            j.gain = a.in[15] + l * 1024; j.dst = (bf16_t*)(ws + WS_W1) + (size_t)le * 1024 * 1024; j.lddst = 1024; j.map = 1; j.mparam = up ? 4 : 0; }
        else { const int rr = r - 64; j.src = a.in[22] + (size_t)le * 512 * 1024; j.ldsrc = 1024; j.k0 = (rr >> 2) * 64; j.n0 = (rr & 3) * 256;
            j.dst = (bf16_t*)(ws + WS_W2) + (size_t)le * 1024 * 512; j.lddst = 512; }
        return;
    }
    t -= NCONV_EXP;
    if (t < 16) { const int g = t >> 2; j.src = a.in[2] + g * 65536; j.ldsrc = 256; j.k0 = (t & 3) * 64; j.n0 = 0; j.gain = a.in[1] + g * 256; j.cvec = a.in[4] + g * 256;
        j.dst = (bf16_t*)(ws + WS_WPOOL) + g * 65536; j.lddst = 256; return; }
    t -= 16;
    if (t < 32) { const int nt = t & 1; j.src = a.in[6]; j.ldsrc = 320; j.k0 = (t >> 1) * 64; j.n0 = nt * 256; j.width = nt ? 64 : 256; j.gain = a.in[5];
        j.dst = (bf16_t*)(ws + WS_WDOWN); j.lddst = 1024; j.map = nt ? 3 : 0; return; }
    t -= 32;
    if (t < 32) { const int nt = t & 1; j.src = a.in[11]; j.ldsrc = 384; j.k0 = (t >> 1) * 64; j.n0 = nt * 256; j.width = nt ? 128 : 256; j.gain = a.in[10];
        j.dst = (bf16_t*)(ws + WS_WDOWN); j.lddst = 1024; j.mparam = 320; return; }
    t -= 32;
    if (t < 32) { const int uv = t >> 4, tt = t & 15; j.src = a.in[uv ? 9 : 8]; j.ldsrc = 1024; j.k0 = (tt >> 2) * 64; j.n0 = (tt & 3) * 256; j.gain = a.in[7];
        j.dst = (bf16_t*)(ws + WS_WUPKV); j.lddst = 256; j.mparam = uv ? 1024 : 0; return; }
    t -= 32;
    if (t < 36) { j.src = a.in[13]; j.ldsrc = 1536; j.k0 = (t / 6) * 64; j.n0 = (t % 6) * 256; j.gain = a.in[12]; j.cscale = QSCALE;
        j.dst = (bf16_t*)(ws + WS_WUPQ); j.lddst = 384; j.map = 4; return; }
    t -= 36;
    j.src = a.in[14]; j.ldsrc = 1024; j.k0 = (t >> 2) * 64; j.n0 = (t & 3) * 256; j.dst = (bf16_t*)(ws + WS_WO); j.lddst = 1024;
}
DEVI void conv_tile(const ConvJob& j, float* tile) {
    const int tid = threadIdx.x, w = tid >> 6, lane = tid & 63, n4 = lane * 4;
    if (n4 < j.width) {
#pragma unroll
        for (int i = 0; i < 8; ++i) { const int k = w + 8 * i;
            f32x4 v = *(const f32x4*)(j.src + (size_t)(j.k0 + k) * j.ldsrc + j.n0 + n4);
            const float g = j.gain ? j.gain[j.k0 + k] : 1.f;
            float* tp = tile + k * 257 + n4; tp[0] = v[0] * g; tp[1] = v[1] * g; tp[2] = v[2] * g; tp[3] = v[3] * g; }
    }
    __syncthreads();
#pragma unroll
    for (int i = 0; i < 4; ++i) { const int q = tid + 512 * i, kp = q & 7, nl = q >> 3;
        if (nl < j.width) {
            const float cs = j.cscale * (j.cvec ? j.cvec[j.n0 + nl] : 1.f);
            const float* tp = tile + (8 * kp) * 257 + nl;
            u32x4 o; o.x = cvt_pk(tp[0] * cs, tp[257] * cs); o.y = cvt_pk(tp[2 * 257] * cs, tp[3 * 257] * cs); o.z = cvt_pk(tp[4 * 257] * cs, tp[5 * 257] * cs); o.w = cvt_pk(tp[6 * 257] * cs, tp[7 * 257] * cs);
            const int row = dst_row(j.map, j.mparam, j.n0 + nl);
            *(u32x4*)(j.dst + (size_t)row * j.lddst + j.k0 + 8 * kp) = o;
        }
    }
    __syncthreads();
}
__device__ const double ROPE_THETA_TAB[32] = {1.0, 0.7498942093324559, 0.5623413251903491, 0.4216965034285822, 0.31622776601683794, 0.23713737056616552, 0.1778279410038923, 0.1333521432163324, 0.1, 0.07498942093324558, 0.05623413251903491, 0.042169650342858224, 0.03162277660168379, 0.023713737056616554, 0.01778279410038923, 0.01333521432163324, 0.01, 0.007498942093324558, 0.005623413251903491, 0.004216965034285823, 0.0031622776601683794, 0.0023713737056616554, 0.0017782794100389228, 0.001333521432163324, 0.001, 0.0007498942093324559, 0.0005623413251903491, 0.00042169650342858224, 0.00031622776601683794, 0.00023713737056616554, 0.00017782794100389227, 0.0001333521432163324};
DEVI void sincos_d(double a, float& sn, float& cs) {
    const double t = a * 0.15915494309189535;
    const double fr = t - __builtin_rint(t);
    const double q = __builtin_rint(fr * 4.0);
    const double y = (fr - q * 0.25) * 6.283185307179586;
    const double y2 = y * y;
    double s = y * (1.0 + y2 * (-1.0 / 6 + y2 * (1.0 / 120 + y2 * (-1.0 / 5040 + y2 * (1.0 / 362880 + y2 * (-1.0 / 39916800 + y2 * (1.0 / 6227020800.0)))))));
    double c = 1.0 + y2 * (-0.5 + y2 * (1.0 / 24 + y2 * (-1.0 / 720 + y2 * (1.0 / 40320 + y2 * (-1.0 / 3628800 + y2 * (1.0 / 479001600.0))))));
    const int qi = ((int)q) & 3;
    double so, co;
    if (qi == 0) { so = s; co = c; } else if (qi == 1) { so = c; co = -s; } else if (qi == 2) { so = -s; co = -c; } else { so = -c; co = s; }
    sn = (float)so; cs = (float)co;
}
DEVI void phase_prologue(const Args& a, unsigned char* lds) {
    float* tile = (float*)lds;
    for (int t = blockIdx.x; t < NCONV; t += gridDim.x) { ConvJob j; conv_decode(a, t, j); conv_tile(j, tile); }
    const int gtid = blockIdx.x * NTHREADS + threadIdx.x, gn = gridDim.x * NTHREADS;
    unsigned char* ws = a.ws;
    { u32x4* z = (u32x4*)((bf16_t*)(ws + WS_WDOWN) + 704 * 1024); for (int i = gtid; i < 64 * 1024 * 2 / 16; i += gn) z[i] = (u32x4){0u, 0u, 0u, 0u}; }
    { float* wr = (float*)(ws + WS_WR);
      for (int i = gtid; i < 2 * 36 * 1024; i += gn) { const int l = i / (36 * 1024), r = i - l * 36 * 1024, jj = r >> 10, k = r & 1023;
          const float g = a.in[15][l * 1024 + k];
          wr[i] = g * (jj < 4 ? a.in[16][(size_t)(l * 1024 + k) * 4 + jj] : a.in[18][(size_t)(l * 1024 + k) * 32 + (jj - 4)]); } }
    { float* pb = (float*)(ws + WS_PBIAS); for (int i = gtid; i < 1024; i += gn) pb[i] = a.in[3][i] * a.in[4][i]; }
    { float* rc = (float*)(ws + WS_ROPE); float* rs = rc + SEQ * 32;
      for (int i = gtid; i < SEQ * 32; i += gn) { const int pos = i >> 5, k = i & 31; const float th = (float)ROPE_THETA_TAB[k]; const float ang = (float)pos * th;
          float sn, cs; sincos_d((double)ang, sn, cs); rc[i] = cs; rs[i] = sn; } }
}

template <int WIN>
DEVI void pool_channel(const float* xc, int pos0, const float* rstd, bf16_t* outc) {
    float ring[16];
#pragma unroll
    for (int u = 0; u < 16; ++u) ring[u] = 0.f;
    float P = 0.f;
    for (int blk = 0; blk < 5; ++blk) {
#pragma unroll
        for (int u = 0; u < 16; ++u) {
            const int rr = blk * 16 + u;
            if (rr < 79) {
                const int pos = pos0 - 15 + rr;
                const float v = (pos >= 0) ? xc[(long)pos * DM] * rstd[rr] : 0.f;
                P += v;
                const float Pold = ring[(u - WIN) & 15];
                ring[u] = P;
                if (rr >= 15) { const int cnt = (pos + 1 < WIN) ? pos + 1 : WIN; const float mean = (P - Pold) / (float)cnt;
                    outc[(long)(rr - 15) * DM] = (bf16_t)(cvt_pk(mean - v, 0.f) & 0xffffu); }
            }
        }
    }
}
DEVI void phase_pool_prep(const Args& a, unsigned char* lds) {
    const float* x = a.in[0]; bf16_t* PB = (bf16_t*)(a.ws + WS_PB);
    float* rstd = (float*)lds;
    const int tid = threadIdx.x, wid = tid >> 6, lane = tid & 63;
    for (int c = blockIdx.x; c < T_TOK / 64; c += gridDim.x) {
        const int b = c >> 7, pos0 = (c & 127) * 64;
        const float* xb = x + (size_t)b * SEQ * DM;
        for (int rr = wid; rr < 79; rr += NWAVES) {
            const int pos = pos0 - 15 + rr; float r = 0.f;
            if (pos >= 0) { const f32x4* xr = (const f32x4*)(xb + (size_t)pos * DM) + lane; float s = 0.f;
#pragma unroll
                for (int j = 0; j < 4; ++j) { const f32x4 v = xr[64 * j]; s += (v[0] * v[0] + v[1] * v[1]) + (v[2] * v[2] + v[3] * v[3]); }
                r = rsqrtf(wave_sum(s) * (1.f / DM) + EPS); }
            if (lane == 0) rstd[rr] = r;
        }
        __syncthreads();
#pragma unroll
        for (int pass = 0; pass < 2; ++pass) {
            const int ch = tid + 512 * pass, g = __builtin_amdgcn_readfirstlane(ch >> 8);
            const float* xc = xb + ch; bf16_t* oc = PB + ((size_t)b * SEQ + pos0) * DM + ch;
            if (g == 0) pool_channel<2>(xc, pos0, rstd, oc); else if (g == 1) pool_channel<4>(xc, pos0, rstd, oc);
            else if (g == 2) pool_channel<8>(xc, pos0, rstd, oc); else pool_channel<16>(xc, pos0, rstd, oc);
        }
        __syncthreads();
    }
}

DEVI void phase_route(const Args& a, int layer, unsigned char* lds) {
    const float* X = (const float*)(a.ws + WS_X);
    const float* Wr = (const float*)(a.ws + WS_WR) + layer * 36 * 1024;
    const float* bg = a.in[17] + layer * 4; const float* be = a.in[19] + layer * 32;
    unsigned* WH = (unsigned*)(a.ws + WS_WH);
    u32x4* TOKR = (u32x4*)(a.ws + WS_TOKR);
    float* lg = (float*)lds;
    int* ea = (int*)(lds + 4 * 16 * 40 * 4);
    int* eb = ea + 64;
    const int tid = threadIdx.x, wid = tid >> 6, lane = tid & 63;
    for (int unit = blockIdx.x; unit < T_TOK / 64; unit += gridDim.x) {
        int e0 = 0, e1 = 0; float w0 = 0.f, w1 = 0.f, rstd_t = 0.f;
        if (wid < 4) {
            const int tok0 = unit * 64 + wid * 16, r = lane & 15, kq = lane >> 4;
            const float* xr = X + (size_t)(tok0 + r) * DM + 4 * kq;
            const int c2 = (32 + r < 36) ? 32 + r : 35;
            const float* wp0 = Wr + (size_t)r * 1024 + 4 * kq; const float* wp1 = Wr + (size_t)(16 + r) * 1024 + 4 * kq; const float* wp2 = Wr + (size_t)c2 * 1024 + 4 * kq;
            f32x4 acc0 = {0.f, 0.f, 0.f, 0.f}, acc1 = acc0, acc2 = acc0; float ss = 0.f;
            for (int s = 0; s < 64; ++s) {
                const f32x4 xv = *(const f32x4*)(xr + 16 * s), a0 = *(const f32x4*)(wp0 + 16 * s), a1 = *(const f32x4*)(wp1 + 16 * s), a2 = *(const f32x4*)(wp2 + 16 * s);
                ss += (xv[0] * xv[0] + xv[1] * xv[1]) + (xv[2] * xv[2] + xv[3] * xv[3]);
#pragma unroll
                for (int uu = 0; uu < 4; ++uu) {
                    acc0 = __builtin_amdgcn_mfma_f32_16x16x4f32(xv[uu], a0[uu], acc0, 0, 0, 0);
                    acc1 = __builtin_amdgcn_mfma_f32_16x16x4f32(xv[uu], a1[uu], acc1, 0, 0, 0);
                    acc2 = __builtin_amdgcn_mfma_f32_16x16x4f32(xv[uu], a2[uu], acc2, 0, 0, 0);
                }
            }
            ss += __shfl_xor(ss, 16); ss += __shfl_xor(ss, 32);
            const float rstd = rsqrtf(ss * (1.f / DM) + EPS);
            float* lw = lg + wid * 16 * 40;
#pragma unroll
            for (int j = 0; j < 4; ++j) { const int trow = 4 * kq + j; lw[trow * 40 + r] = acc0[j]; lw[trow * 40 + 16 + r] = acc1[j]; if (r < 4) lw[trow * 40 + 32 + r] = acc2[j]; }
            asm volatile("s_waitcnt lgkmcnt(0)" ::: "memory");
            if (lane < 16) {
                const float* L = lw + lane * 40;
                float gl[4];
#pragma unroll
                for (int j = 0; j < 4; ++j) gl[j] = L[j] * rstd + bg[j];
                int gi = 0; float gm = gl[0];
#pragma unroll
                for (int j = 1; j < 4; ++j) if (gl[j] > gm) { gm = gl[j]; gi = j; }
                float den = 0.f;
#pragma unroll
                for (int j = 0; j < 4; ++j) den += __expf(gl[j] - gm);
                const float gprob = 1.f / den;
                float el[8];
#pragma unroll
                for (int j = 0; j < 8; ++j) el[j] = L[4 + 8 * gi + j] * rstd + be[8 * gi + j];
                int ia = 0; float ma = el[0];
#pragma unroll
                for (int j = 1; j < 8; ++j) if (el[j] > ma) { ma = el[j]; ia = j; }
                int ib = -1; float mb = -3.0e38f;
#pragma unroll
                for (int j = 0; j < 8; ++j) if (j != ia && el[j] > mb) { mb = el[j]; ib = j; }
                const float pb = __expf(mb - ma), inv = 1.f / (1.f + pb);
                w0 = gprob * inv; w1 = gprob * pb * inv; e0 = gi * 8 + ia; e1 = gi * 8 + ib; rstd_t = rstd;
                ea[wid * 16 + lane] = e0; eb[wid * 16 + lane] = e1;
            }
        }
        __syncthreads();
        if (wid < 4 && lane < 16) {
            const int t = wid * 16 + lane; int s0 = 0, s1 = 0;
            for (int q = 0; q < t; ++q) { const int qa = ea[q], qb = eb[q]; s0 += (qa == e0) + (qb == e0); s1 += (qa == e1) + (qb == e1); }
            TOKR[unit * 64 + t] = (u32x4){(unsigned)(e0 | (e1 << 8) | (s0 << 16) | (s1 << 24)), __float_as_uint(w0), __float_as_uint(w1), __float_as_uint(rstd_t)};
        }
        if (tid >= 256 && tid < 256 + NEXP) { const int e = tid - 256; unsigned c = 0; for (int q = 0; q < 64; ++q) c += (ea[q] == e) + (eb[q] == e); WH[unit * NEXP + e] = c; }
        __syncthreads();
    }
}

DEVI int build_tiles(const unsigned* cnt, int* tstart) {
    if (threadIdx.x == 0) { int acc = 0; for (int e = 0; e < NEXP; ++e) { tstart[e] = acc; acc += (int)((cnt[e] + 255u) >> 8); } tstart[NEXP] = acc; }
    __syncthreads();
    return tstart[NEXP];
}
DEVI void phase_gather(const Args& a, int layer, unsigned char* lds) {
    const unsigned* WH = (const unsigned*)(a.ws + WS_WH);
    const u32x4* TOKR = (const u32x4*)(a.ws + WS_TOKR);
    unsigned* CNT = (unsigned*)(a.ws + WS_CNT) + layer * 64;
    const bf16_t* XB = (const bf16_t*)(a.ws + WS_XB); bf16_t* XG = (bf16_t*)(a.ws + WS_XG); u32x4* RI = (u32x4*)(a.ws + WS_RI);
    int* tstart = (int*)lds;
    unsigned* cntl = (unsigned*)(lds + 256);
    unsigned* basel = cntl + 32;
    const int tid = threadIdx.x, wid = tid >> 6, lane = tid & 63;
    for (int unit = blockIdx.x; unit < T_TOK / 64; unit += gridDim.x) {
        if (tid < NEXP) { unsigned tot = 0, bs = 0; for (int u = 0; u < T_TOK / 64; ++u) { const unsigned c = WH[u * NEXP + tid]; bs += (u < unit) ? c : 0u; tot += c; }
            cntl[tid] = tot; basel[tid] = bs; if (unit == 0) CNT[tid] = tot; }
        __syncthreads();
        build_tiles(cntl, tstart);
        for (int i = 0; i < 8; ++i) {
            const int tok = unit * 64 + wid * 8 + i;
            const u32x4 tr = TOKR[tok];
            const u32x4* src = (const u32x4*)(XB + (size_t)tok * DM); const u32x4 v0 = src[lane], v1 = src[64 + lane];
#pragma unroll
            for (int k = 0; k < 2; ++k) {
                const int e = (tr.x >> (8 * k)) & 0xff, sk = (tr.x >> (16 + 8 * k)) & 0xff;
                const size_t row = (size_t)tstart[e] * 256 + basel[e] + sk;
                u32x4* dst = (u32x4*)(XG + row * DM); dst[lane] = v0; dst[64 + lane] = v1;
                if (lane == 0) RI[row] = (u32x4){(unsigned)(tok * 2 + k), k ? tr.z : tr.y, tr.w, 0u};
            }
        }
        if (unit < NEXP) {
            const int e = unit; const size_t r0 = (size_t)tstart[e] * 256 + cntl[e], r1 = (size_t)tstart[e + 1] * 256;
            for (size_t row = r0 + wid; row < r1; row += NWAVES) {
                u32x4* dst = (u32x4*)(XG + row * DM); dst[lane] = (u32x4){0u, 0u, 0u, 0u}; dst[64 + lane] = (u32x4){0u, 0u, 0u, 0u};
                if (lane == 0) RI[row] = (u32x4){0xffffffffu, 0u, 0u, 0u};
            }
        }
        __syncthreads();
    }
}
DEVI void phase_moe1(const Args& a, int layer, unsigned char* lds) {
    const unsigned* cnt = (const unsigned*)(a.ws + WS_CNT) + layer * 64;
    int* tstart = (int*)(lds + TS_OFF); const int NT = build_tiles(cnt, tstart);
    SchedMoE S{(const bf16_t*)(a.ws + WS_XG), (const bf16_t*)(a.ws + WS_W1) + (size_t)layer * NEXP * 1024 * 1024, tstart, 1024, 1024, NT, (int)gridDim.x, (int)blockIdx.x};
    EpiSwiGLU E{(const u32x4*)(a.ws + WS_RI), (bf16_t*)(a.ws + WS_H)};
    GEMM_PHASE(5, (GemmDesc{1024, 1024, 1024}), S, E);
}
DEVI void phase_moe2(const Args& a, int layer, unsigned char* lds) {
    const unsigned* cnt = (const unsigned*)(a.ws + WS_CNT) + layer * 64;
    int* tstart = (int*)(lds + TS_OFF); const int NT = build_tiles(cnt, tstart);
    SchedMoE S{(const bf16_t*)(a.ws + WS_H), (const bf16_t*)(a.ws + WS_W2) + (size_t)layer * NEXP * 1024 * 512, tstart, 512, 512, NT, (int)gridDim.x, (int)blockIdx.x};
    EpiMoeDown E{(const u32x4*)(a.ws + WS_RI), (bf16_t*)(a.ws + WS_Y)};
#if (NAIVE_MASK >> 6) & 1u
    { Unit u; const u32x4* RI = (const u32x4*)(a.ws + WS_RI); bf16_t* Y = (bf16_t*)(a.ws + WS_Y);
      for (int i = 0; S.next(i, u); ++i) {
        for (int it = threadIdx.x; it < 256 * 32; it += NTHREADS) {
            const int r = it >> 5, cg = (it & 31) * 8;
            const bf16_t* hrow = u.A + (size_t)r * 512; const bf16_t* wrow = u.B + (size_t)cg * 512;
            float acc[8] = {0.f, 0.f, 0.f, 0.f, 0.f, 0.f, 0.f, 0.f};
            for (int k = 0; k < 512; ++k) { const float h = bf2f(hrow[k]);
#pragma unroll
                for (int jj = 0; jj < 8; ++jj) acc[jj] += h * bf2f(wrow[(size_t)jj * 512 + k]); }
            const size_t row = (size_t)u.pm * 256 + r; const u32x4 ri = RI[row]; const int dest = (int)ri.x; const float w = __uint_as_float(ri.y);
            if (dest >= 0) { u32x4 o; o.x = cvt_pk(acc[0] * w, acc[1] * w); o.y = cvt_pk(acc[2] * w, acc[3] * w); o.z = cvt_pk(acc[4] * w, acc[5] * w); o.w = cvt_pk(acc[6] * w, acc[7] * w);
                *(u32x4*)(Y + ((size_t)(dest & 1) * T_TOK + (size_t)(dest >> 1)) * DM + u.pn * 256 + cg) = o; }
        }
      } }
#else
    GEMM_PHASE(6, (GemmDesc{512, 512, 512}), S, E);
#endif
}
template <bool FINAL>
DEVI void phase_resid(const Args& a) {
    float* X = (float*)(a.ws + WS_X); const bf16_t* Y = (const bf16_t*)(a.ws + WS_Y); bf16_t* XB = (bf16_t*)(a.ws + WS_XB); float* RS2 = (float*)(a.ws + WS_RS2);
    const int wid = threadIdx.x >> 6, lane = threadIdx.x & 63;
    for (int row = blockIdx.x * NWAVES + wid; row < T_TOK; row += gridDim.x * NWAVES) {
        f32x4 v[4]; float s = 0.f;
#pragma unroll
        for (int j = 0; j < 4; ++j) {
            const size_t off = (size_t)row * DM + 256 * j + 4 * lane;
            v[j] = *(const f32x4*)(X + off);
            const u32x2 y0 = *(const u32x2*)(Y + off), y1 = *(const u32x2*)(Y + (size_t)T_TOK * DM + off);
            v[j][0] += bflo(y0.x) + bflo(y1.x); v[j][1] += bfhi(y0.x) + bfhi(y1.x); v[j][2] += bflo(y0.y) + bflo(y1.y); v[j][3] += bfhi(y0.y) + bfhi(y1.y);
            s += (v[j][0] * v[j][0] + v[j][1] * v[j][1]) + (v[j][2] * v[j][2] + v[j][3] * v[j][3]);
        }
        const float rstd = rsqrtf(wave_sum(s) * (1.f / DM) + EPS);
#pragma unroll
        for (int j = 0; j < 4; ++j) {
            const size_t off = (size_t)row * DM + 256 * j + 4 * lane;
            if (FINAL) { const f32x4 g = *(const f32x4*)(a.in[23] + 256 * j + 4 * lane); *(f32x4*)(a.out + off) = v[j] * rstd * g; }
            else { *(f32x4*)(X + off) = v[j]; u32x2 w; w.x = cvt_pk(v[j][0], v[j][1]); w.y = cvt_pk(v[j][2], v[j][3]); *(u32x2*)(XB + off) = w; }
        }
        if (!FINAL && lane == 0) RS2[row] = rstd;
    }
}

DEVI void phase_attn_naive(const Args& a, unsigned char* lds) {
    const bf16_t* Q = (const bf16_t*)(a.ws + WS_Q); const bf16_t* KN = (const bf16_t*)(a.ws + WS_KN); const bf16_t* KR = (const bf16_t*)(a.ws + WS_KR);
    const bf16_t* V = (const bf16_t*)(a.ws + WS_V); bf16_t* O = (bf16_t*)(a.ws + WS_O);
    const int wid = threadIdx.x >> 6, lane = threadIdx.x & 63;
    float* qs = (float*)lds + wid * DQK;
    for (int unit = blockIdx.x; unit < 2 * NH * (SEQ / 8); unit += gridDim.x) {
        const int bh = unit >> 10, s = (unit & 1023) * 8 + wid, b = bh >> 3, h = bh & 7;
        const bf16_t* qp = Q + ((size_t)bh * SEQ + s) * DQK;
        for (int i = lane; i < DQK; i += 64) qs[i] = bf2f(qp[i]);
        asm volatile("s_waitcnt lgkmcnt(0)" ::: "memory");
        const int nt = (s >> 6) + 1; float m = -1e30f, l = 0.f, o0 = 0.f, o1 = 0.f;
        for (int jt = 0; jt < nt; ++jt) {
            const int key = jt * 64 + lane;
            const bf16_t* kn = KN + ((size_t)bh * SEQ + key) * DNOPE; const bf16_t* kr = KR + ((size_t)b * SEQ + key) * DROPE;
            float sc = 0.f;
            for (int d = 0; d < DNOPE; d += 8) { const u32x4 kv = *(const u32x4*)(kn + d); const f32x4 q0 = *(const f32x4*)(qs + d), q1 = *(const f32x4*)(qs + d + 4);
                sc += q0[0] * bflo(kv.x) + q0[1] * bfhi(kv.x) + q0[2] * bflo(kv.y) + q0[3] * bfhi(kv.y) + q1[0] * bflo(kv.z) + q1[1] * bfhi(kv.z) + q1[2] * bflo(kv.w) + q1[3] * bfhi(kv.w); }
            for (int d = 0; d < DROPE; d += 8) { const u32x4 kv = *(const u32x4*)(kr + d); const f32x4 q0 = *(const f32x4*)(qs + DNOPE + d), q1 = *(const f32x4*)(qs + DNOPE + d + 4);
                sc += q0[0] * bflo(kv.x) + q0[1] * bfhi(kv.x) + q0[2] * bflo(kv.y) + q0[3] * bfhi(kv.y) + q1[0] * bflo(kv.z) + q1[1] * bfhi(kv.z) + q1[2] * bflo(kv.w) + q1[3] * bfhi(kv.w); }
            const float mn = fmaxf(m, wave_max(sc)), alpha = __builtin_amdgcn_exp2f(m - mn), p = __builtin_amdgcn_exp2f(sc - mn);
            l = l * alpha + wave_sum(p); o0 *= alpha; o1 *= alpha; m = mn;
            const bf16_t* vp = V + ((size_t)bh * SEQ + jt * 64) * DV + 2 * lane;
            for (int j = 0; j < 64; ++j) { const float pj = __shfl(p, j); const unsigned vv = *(const unsigned*)(vp + j * DV); o0 += pj * bflo(vv); o1 += pj * bfhi(vv); }
        }
        const float il = 1.f / l;
        *(unsigned*)(O + ((size_t)b * SEQ + s) * DM + h * DV + 2 * lane) = cvt_pk(o0 * il, o1 * il);
        asm volatile("s_waitcnt lgkmcnt(0)" ::: "memory");
    }
}

namespace att {
typedef short s16x4 __attribute__((ext_vector_type(4)));
typedef float f32x16 __attribute__((ext_vector_type(16)));
constexpr int SHM_KN = 16384, SHM_KR = 8192, SHM_V = 16384;
constexpr int OFF_V = 0, OFF_KN = 32768, OFF_KR = 65536, OFF_WS = 81920, OFF_QR = 83968;
constexpr float THR2 = 11.0f;
#define KSWZ(row, colB) ((row) * 256 + ((colB) ^ (((row) & 7) << 4)))
#define RSWZ(row, colB) ((row) * 128 + ((colB) ^ ((((row) >> 1) & 7) << 4)))
#define SBAR() __builtin_amdgcn_sched_barrier(0)
DEVI int v_st(int k, int c) { const int kk = (k & ~0xC) | ((k & 4) << 1) | ((k & 8) >> 1); return ((kk >> 3) * 4 + (c >> 5)) * 512 + ((kk & 7) * 32 + (c & 31)) * 2; }
DEVI int v_rd_base(int lane) { return ((lane & 3) << 3) | (((lane >> 2) & 3) << 6) | (((lane >> 4) & 1) << 5) | (((lane >> 5) & 1) << 8); }
constexpr int v_rd_off(int d0, int ks, int half) { return d0 * 512 + ks * 4096 + half * 2048; }
DEVI int crow(int r, int hi) { return (r & 3) + 8 * (r >> 2) + 4 * hi; }

template <int KB>
DEVI void qkt(f32x16& p0, f32x16& p1, const char* lds, int r32, int hi, const bf16x8* qr, const char* qlds) {
    p0 = f32x16{}; p1 = f32x16{};
    const char* kb[4]; const char* kr[4];
#pragma unroll
    for (int dd = 0; dd < 4; ++dd) { kb[dd] = lds + OFF_KN + KB * SHM_KN + KSWZ(r32, (dd * 16 + hi * 8) * 2); kr[dd] = lds + OFF_KR + KB * SHM_KR + RSWZ(r32, (dd * 16 + hi * 8) * 2); }
#pragma unroll
    for (int d0 = 0; d0 < 8; ++d0) { const char* a = kb[d0 & 3] + (d0 >> 2) * 128;
        const bf16x8 b0 = *reinterpret_cast<const bf16x8*>(a), b1 = *reinterpret_cast<const bf16x8*>(a + 32 * 256);
        p0 = __builtin_amdgcn_mfma_f32_32x32x16_bf16(b0, qr[d0], p0, 0, 0, 0);
        p1 = __builtin_amdgcn_mfma_f32_32x32x16_bf16(b1, qr[d0], p1, 0, 0, 0); }
#pragma unroll
    for (int d0 = 0; d0 < 4; ++d0) { const char* a = kr[d0];
        const bf16x8 b0 = *reinterpret_cast<const bf16x8*>(a), b1 = *reinterpret_cast<const bf16x8*>(a + 32 * 128);
        const bf16x8 qv = *reinterpret_cast<const bf16x8*>(qlds + RSWZ(r32, (d0 * 16 + hi * 8) * 2));
        p0 = __builtin_amdgcn_mfma_f32_32x32x16_bf16(b0, qv, p0, 0, 0, 0);
        p1 = __builtin_amdgcn_mfma_f32_32x32x16_bf16(b1, qv, p1, 0, 0, 0); }
}
template <int VB>
DEVI void pv_tile(f32x16* o, int vb0, bf16x8 pa0, bf16x8 pa1, bf16x8 pa2, bf16x8 pa3) {
#define TRRD(dst, off) asm volatile("ds_read_b64_tr_b16 %0, %1 offset:%2" : "=&v"(dst) : "v"(vb0), "i"(off) : "memory")
#define PV_D0(d0) do { s16x4 l0, l1, l2, l3, h0, h1, h2, h3; constexpr int b_ = OFF_V + VB * SHM_V + v_rd_off(d0, 0, 0); \
        TRRD(l0, b_); TRRD(h0, b_ + 2048); TRRD(l1, b_ + 4096); TRRD(h1, b_ + 6144); TRRD(l2, b_ + 8192); TRRD(h2, b_ + 10240); TRRD(l3, b_ + 12288); TRRD(h3, b_ + 14336); \
        asm volatile("s_waitcnt lgkmcnt(0)" ::: "memory"); SBAR(); \
        o[d0] = __builtin_amdgcn_mfma_f32_32x32x16_bf16(pa0, (bf16x8){l0[0], l0[1], l0[2], l0[3], h0[0], h0[1], h0[2], h0[3]}, o[d0], 0, 0, 0); \
        o[d0] = __builtin_amdgcn_mfma_f32_32x32x16_bf16(pa1, (bf16x8){l1[0], l1[1], l1[2], l1[3], h1[0], h1[1], h1[2], h1[3]}, o[d0], 0, 0, 0); \
        o[d0] = __builtin_amdgcn_mfma_f32_32x32x16_bf16(pa2, (bf16x8){l2[0], l2[1], l2[2], l2[3], h2[0], h2[1], h2[2], h2[3]}, o[d0], 0, 0, 0); \
        o[d0] = __builtin_amdgcn_mfma_f32_32x32x16_bf16(pa3, (bf16x8){l3[0], l3[1], l3[2], l3[3], h3[0], h3[1], h3[2], h3[3]}, o[d0], 0, 0, 0); } while (0)
    PV_D0(0); PV_D0(1); PV_D0(2); PV_D0(3);
#undef PV_D0
#undef TRRD
}
DEVI void softmax_tile(f32x16& p0, f32x16& p1, float& m_reg, float& l_reg, float& alpha, bf16x8& pa0, bf16x8& pa1, bf16x8& pa2, bf16x8& pa3) {
    float pmax = p0[0];
#pragma unroll
    for (int r = 1; r < 16; ++r) pmax = fmaxf(pmax, p0[r]);
#pragma unroll
    for (int r = 0; r < 16; ++r) pmax = fmaxf(pmax, p1[r]);
    { auto rr = __builtin_amdgcn_permlane32_swap(__float_as_uint(pmax), __float_as_uint(pmax), false, false); pmax = fmaxf(__uint_as_float(rr[0]), __uint_as_float(rr[1])); }
    float mn;
    if (__builtin_expect(__all((pmax - m_reg) <= THR2), 1)) { mn = m_reg; alpha = 1.f; }
    else { mn = fmaxf(m_reg, pmax); alpha = __builtin_amdgcn_exp2f(m_reg - mn); m_reg = mn; }
#pragma unroll
    for (int r = 0; r < 16; ++r) { p0[r] = __builtin_amdgcn_exp2f(p0[r] - mn); p1[r] = __builtin_amdgcn_exp2f(p1[r] - mn); }
    float ps = 0.f;
#pragma unroll
    for (int r = 0; r < 16; ++r) ps += p0[r];
#pragma unroll
    for (int r = 0; r < 16; ++r) ps += p1[r];
    { auto rr = __builtin_amdgcn_permlane32_swap(__float_as_uint(ps), __float_as_uint(ps), false, false); ps = __uint_as_float(rr[0]) + __uint_as_float(rr[1]); }
    l_reg = l_reg * alpha + ps;
#define PK4(P, B_, OUT) do { unsigned a0 = cvt_pk(P[B_ + 0], P[B_ + 1]), a1 = cvt_pk(P[B_ + 2], P[B_ + 3]); \
        unsigned b0 = cvt_pk(P[B_ + 4], P[B_ + 5]), b1 = cvt_pk(P[B_ + 6], P[B_ + 7]); \
        auto r0 = __builtin_amdgcn_permlane32_swap(a0, b0, false, false); auto r1 = __builtin_amdgcn_permlane32_swap(a1, b1, false, false); \
        u32x4 w = {r0[0], r1[0], r0[1], r1[1]}; OUT = *reinterpret_cast<bf16x8*>(&w); } while (0)
    PK4(p0, 0, pa0); PK4(p0, 8, pa1); PK4(p1, 0, pa2); PK4(p1, 8, pa3);
#undef PK4
}

DEVI void attn_unit(int b, int h, int qb, const bf16_t* Q, const bf16_t* KN, const bf16_t* KR, const bf16_t* V, bf16_t* O, char* lds) {
    const int tid = threadIdx.x, wid = __builtin_amdgcn_readfirstlane(tid >> 6), lane = tid & 63, r32 = lane & 31, hi = lane >> 5;
    const int bh = b * NH + h, q0 = qb * 256, NT = 4 * qb + 4, wch = 4 * qb + (wid >> 1);
    const bf16_t* Kh = KN + (size_t)bh * SEQ * DNOPE; const bf16_t* Vh = V + (size_t)bh * SEQ * DV; const bf16_t* Rh = KR + (size_t)b * SEQ * DROPE;
    float* ws = (float*)(lds + OFF_WS) + wid * 64; float* li_l = ws; float* al_l = ws + 32;
    bf16x8 qr[8]; char* qlds = lds + OFF_QR + wid * 4096;
#define BLD(rs, vo, so) __builtin_bit_cast(bf16x8, __builtin_amdgcn_raw_buffer_load_b128(rs, vo, so, 0))
    { const __amdgpu_buffer_rsrc_t rsQ = __builtin_amdgcn_make_buffer_rsrc((void*)(Q + ((size_t)bh * SEQ + q0 + wid * 32) * DQK), 0, 32 * DQK * 2, 0x00020000);
      const unsigned qo = (unsigned)(r32 * DQK + hi * 8) * 2u;
#pragma unroll
      for (int d0 = 0; d0 < 8; ++d0) qr[d0] = BLD(rsQ, qo, d0 * 32);
#pragma unroll
      for (int d0 = 0; d0 < 4; ++d0) *reinterpret_cast<bf16x8*>(qlds + RSWZ(r32, (d0 * 16 + hi * 8) * 2)) = BLD(rsQ, qo, DNOPE * 2 + d0 * 32); }
    const int sr = tid >> 4, sc = (tid & 15) * 8, kws = OFF_KN + KSWZ(sr, sc * 2), vst0 = OFF_V + v_st(sr, sc), vst1 = OFF_V + v_st(32 + sr, sc);
    const int rr_ = tid >> 3, rc = (tid & 7) * 8, rws = OFF_KR + RSWZ(rr_, rc * 2);
    const int vb0 = (int)(uintptr_t)lds + v_rd_base(lane);
    bf16x8 st_k0, st_k1, st_v0, st_v1, st_r;
    const __amdgpu_buffer_rsrc_t rsK = __builtin_amdgcn_make_buffer_rsrc((void*)Kh, 0, SEQ * DNOPE * 2, 0x00020000);
    const __amdgpu_buffer_rsrc_t rsV = __builtin_amdgcn_make_buffer_rsrc((void*)Vh, 0, SEQ * DV * 2, 0x00020000);
    const __amdgpu_buffer_rsrc_t rsR = __builtin_amdgcn_make_buffer_rsrc((void*)Rh, 0, SEQ * DROPE * 2, 0x00020000);
    const unsigned kvoff = (unsigned)(sr * 128 + sc) * 2u, roff = (unsigned)(rr_ * 64 + rc) * 2u;
#define SLOAD(t) do { const unsigned so_ = (unsigned)(t) * (64u * 256u); \
        st_k0 = BLD(rsK, kvoff, so_); st_k1 = BLD(rsK, kvoff, so_ + 8192u); st_v0 = BLD(rsV, kvoff, so_); st_v1 = BLD(rsV, kvoff, so_ + 8192u); \
        st_r = BLD(rsR, roff, (unsigned)(t) * (64u * 128u)); } while (0)
#define SWRITE(bf) do { *reinterpret_cast<bf16x8*>(lds + (bf) * SHM_KN + kws) = st_k0; *reinterpret_cast<bf16x8*>(lds + (bf) * SHM_KN + kws + 32 * 256) = st_k1; \
        *reinterpret_cast<bf16x8*>(lds + (bf) * SHM_V + vst0) = st_v0; *reinterpret_cast<bf16x8*>(lds + (bf) * SHM_V + vst1) = st_v1; \
        *reinterpret_cast<bf16x8*>(lds + (bf) * SHM_KR + rws) = st_r; } while (0)
    float m_reg = -1e30f, l_reg = 0.f; f32x16 o[4] = {};
    SLOAD(0); SWRITE(0);
    __syncthreads();
#define STEP(KB, t, more) do { \
        if (more) SLOAD((t) + 1); \
        if ((t) <= wch) { \
            f32x16 p0, p1; float alpha; bf16x8 pa0, pa1, pa2, pa3; \
            qkt<KB>(p0, p1, lds, r32, hi, qr, qlds); \
            softmax_tile(p0, p1, m_reg, l_reg, alpha, pa0, pa1, pa2, pa3); \
            if (__any(alpha < 1.f)) { if (hi == 0) al_l[r32] = alpha; asm volatile("s_waitcnt lgkmcnt(0)" ::: "memory"); \
                _Pragma("unroll") for (int d_ = 0; d_ < 4; ++d_) _Pragma("unroll") for (int r = 0; r < 16; ++r) o[d_][r] *= al_l[crow(r, hi)]; } \
            pv_tile<KB>(o, vb0, pa0, pa1, pa2, pa3); \
        } \
        if (more) SWRITE(1 - (KB)); \
        __syncthreads(); } while (0)
    for (int t = 0; t < NT; t += 2) {
        STEP(0, t, true);
        STEP(1, t + 1, (t + 2 < NT));
    }
    if (hi == 0) li_l[r32] = l_reg;
    asm volatile("s_waitcnt lgkmcnt(0)" ::: "memory");
    const __amdgpu_buffer_rsrc_t rsO = __builtin_amdgcn_make_buffer_rsrc((void*)(O + ((size_t)b * SEQ + q0 + wid * 32) * DM + h * DV), 0, 32 * DM * 2, 0x00020000);
#pragma unroll
    for (int r = 0; r < 16; ++r) { const int orow = crow(r, hi); const float il = __builtin_amdgcn_rcpf(li_l[orow]);
#pragma unroll
        for (int d0 = 0; d0 < 4; ++d0) { const float v = o[d0][r] * il; const float vn = __shfl_xor(v, 1);
            if ((r32 & 1) == 0) __builtin_amdgcn_raw_buffer_store_b32(cvt_pk(v, vn), rsO, (unsigned)(orow * DM + d0 * 32 + r32) * 2u, 0, 0); } }
#undef BLD
#undef SLOAD
#undef SWRITE
#undef STEP
}
}

DEVI void phase_attn(const Args& a, unsigned char* lds) {
    const bf16_t* Q = (const bf16_t*)(a.ws + WS_Q); const bf16_t* KN = (const bf16_t*)(a.ws + WS_KN); const bf16_t* KR = (const bf16_t*)(a.ws + WS_KR);
    const bf16_t* V = (const bf16_t*)(a.ws + WS_V); bf16_t* O = (bf16_t*)(a.ws + WS_O);
    for (int item = blockIdx.x; item < 2 * NH * 16; item += gridDim.x) {
        const int bh = item >> 4, x = item & 15, b = bh >> 3, h = bh & 7;
        att::attn_unit(b, h, 31 - x, Q, KN, KR, V, O, (char*)lds);
        __syncthreads();
        att::attn_unit(b, h, x, Q, KN, KR, V, O, (char*)lds);
        __syncthreads();
    }
}

#define XB_TMO      128
#define XB_XCNT(j)  (256  + 64 * (j))
#define XB_XSUB(j)  (1280 + 64 * (j))
#define XB_XGEN(j)  (2304 + 64 * (j))
#define XB_TOP      3328
#define XB_TOPGEN   3392
#define XCD_BAR_WORDS 3456
#define XB_SPIN_CAP (1u << 18)
__device__ __forceinline__ unsigned xb_ld(unsigned* p)              { return __hip_atomic_load(p, __ATOMIC_RELAXED, __HIP_MEMORY_SCOPE_AGENT); }
__device__ __forceinline__ unsigned xb_add(unsigned* p, unsigned v) { return __hip_atomic_fetch_add(p, v, __ATOMIC_RELAXED, __HIP_MEMORY_SCOPE_AGENT); }
__device__ __forceinline__ unsigned xb_xcc_id() { return (unsigned)__builtin_amdgcn_s_getreg((3 << 11) | 20) & 0xFu; }
#define XB_SPIN(cond, bar) do { unsigned _sp = 0; while (cond) { __builtin_amdgcn_s_sleep(1); \
    if ((++_sp & 255u) == 0u) { if (xb_ld(&(bar)[XB_TMO])) break; if (_sp > XB_SPIN_CAP) { atomicAdd(&(bar)[XB_TMO], 1u); break; } } } } while (0)
struct XcdBarrier { unsigned* bar; unsigned x; volatile LAS unsigned* st; };
__device__ __forceinline__ XcdBarrier xcd_barrier_post(unsigned* bar, volatile LAS unsigned* st) {
    XcdBarrier b; b.bar = bar; b.x = xb_xcc_id(); b.st = st;
    if (threadIdx.x == 0) (void)xb_add(&bar[XB_XCNT(b.x)], 1u);
    return b;
}
__device__ __forceinline__ void xcd_barrier_complete(unsigned* bar, unsigned x, unsigned& nloc, unsigned& nx) {
    const unsigned G = gridDim.x * gridDim.y * gridDim.z;
    unsigned sum, cnt, mine, sp = 0u;
    for (;;) {
        sum = 0u; cnt = 0u; mine = 0u;
#pragma unroll
        for (unsigned j = 0; j < 16; ++j) { const unsigned c = xb_ld(&bar[XB_XCNT(j)]); sum += c; cnt += (c > 0u) ? 1u : 0u; mine = (j == x) ? c : mine; }
        if (sum == G) break;
        __builtin_amdgcn_s_sleep(1);
        if ((++sp & 255u) == 0u) { if (xb_ld(&bar[XB_TMO])) break; if (sp > XB_SPIN_CAP) { atomicAdd(&bar[XB_TMO], 1u); break; } }
    }
    nloc = mine > 0u ? mine : 1u; nx = cnt > 0u ? cnt : 1u;
}
__device__ __forceinline__ void xcd_barrier(const XcdBarrier& b) {
    asm volatile("s_waitcnt vmcnt(0)" ::: "memory");
    __syncthreads();
    if (threadIdx.x == 0) {
        unsigned* bar = b.bar;
        __builtin_amdgcn_s_waitcnt(0);
        unsigned nloc = b.st[0], nx = b.st[1];
        if (nloc == 0u) { xcd_barrier_complete(bar, b.x, nloc, nx); b.st[0] = nloc; b.st[1] = nx; }
        const unsigned old = xb_add(&bar[XB_XSUB(b.x)], 1u);
        const unsigned gen = old / nloc;
        if (old + 1u == (gen + 1u) * nloc) {
            __builtin_amdgcn_fence(__ATOMIC_RELEASE, "agent");
            asm volatile("s_waitcnt vmcnt(0)" ::: "memory");
            const unsigned og = xb_add(&bar[XB_TOP], 1u);
            const unsigned tg = og / nx;
            if (og + 1u == (tg + 1u) * nx) xb_add(&bar[XB_TOPGEN], 1u);
            else XB_SPIN(xb_ld(&bar[XB_TOPGEN]) == tg, bar);
            __builtin_amdgcn_fence(__ATOMIC_ACQUIRE, "agent");
            xb_add(&bar[XB_XGEN(b.x)], 1u);
            asm volatile("s_waitcnt vmcnt(0)" ::: "memory");
        } else {
            XB_SPIN(xb_ld(&bar[XB_XGEN(b.x)]) == gen, bar);
            __builtin_amdgcn_fence(__ATOMIC_ACQUIRE, "agent");
            asm volatile("s_waitcnt vmcnt(0)" ::: "memory");
        }
    }
    __syncthreads();
}

constexpr int NPHASES = 17;
__global__ void __launch_bounds__(NTHREADS, 2) fwd(Args a) {
    extern __shared__ __attribute__((aligned(16))) unsigned char lds[];
    unsigned char* ws = a.ws;
    const int lo = a.ph_lo, hi = a.ph_hi, G = gridDim.x, c = blockIdx.x;
    volatile LAS unsigned* misc = (volatile LAS unsigned*)((LAS unsigned char*)lds + MISC_OFF);
    if (threadIdx.x < 16) misc[threadIdx.x] = 0u;
    __syncthreads();
    XcdBarrier bar; bar.bar = (unsigned*)(ws + WS_CTL) + CW_BAR; bar.x = 0; bar.st = misc;
    if (hi - lo > 1) bar = xcd_barrier_post((unsigned*)(ws + WS_CTL) + CW_BAR, misc);
#ifndef PHMASK
#define PHMASK 0xFFFFFFFFu
#endif
#define IN(k) (((PHMASK >> (k)) & 1u) && lo <= (k) && (k) < hi)
#define SEAM(k) do { if (IN(k) && IN((k) + 1)) xcd_barrier(bar); } while (0)
    if (IN(0)) phase_prologue(a, lds);
    SEAM(0);
    if (IN(1)) phase_pool_prep(a, lds);
    SEAM(1);
    if (IN(2)) {
        SchedDense S{(const bf16_t*)(ws + WS_PB), (const bf16_t*)(ws + WS_WPOOL), 1024, 64, 4, G, c, 256, 65536};
        EpiPool E{a.in[0], (const float*)(ws + WS_PBIAS), (float*)(ws + WS_X), (bf16_t*)(ws + WS_XB)};
        GEMM_PHASE(2, (GemmDesc{1024, 256, 256}), S, E);
    }
    SEAM(2);
    if (IN(3)) phase_route(a, 0, lds);
    SEAM(3);
    if (IN(4)) phase_gather(a, 0, lds);
    SEAM(4);
    if (IN(5)) phase_moe1(a, 0, lds);
    SEAM(5);
    if (IN(6)) phase_moe2(a, 0, lds);
    SEAM(6);
    if (IN(7)) phase_resid<false>(a);
    SEAM(7);
    if (IN(8)) {
        SchedDense S{(const bf16_t*)(ws + WS_XB), (const bf16_t*)(ws + WS_WDOWN), 1024, 64, 3, G, c, 0, (size_t)256 * 1024};
        const float* rc = (const float*)(ws + WS_ROPE);
        EpiDownProj E{(const float*)(ws + WS_RS2), (bf16_t*)(ws + WS_CKV), (bf16_t*)(ws + WS_CQ), (bf16_t*)(ws + WS_KR), (float*)(ws + WS_SSKV), (float*)(ws + WS_SSQ), rc, rc + SEQ * 32};
        GEMM_PHASE(8, (GemmDesc{1024, 1024, 1024}), S, E);
    }
    SEAM(8);
    if (IN(9)) {
        { SchedDense S{(const bf16_t*)(ws + WS_CKV), (const bf16_t*)(ws + WS_WUPKV), 256, 64, 8, G, c, 0, (size_t)256 * 256};
          EpiUpKV E{(const float*)(ws + WS_SSKV), (bf16_t*)(ws + WS_KN), (bf16_t*)(ws + WS_V)};
          GEMM_PHASE(9, (GemmDesc{256, 256, 256}), S, E); }
        { SchedDense S{(const bf16_t*)(ws + WS_CQ), (const bf16_t*)(ws + WS_WUPQ), 384, 64, 6, G, c, 0, (size_t)256 * 384};
          const float* rc = (const float*)(ws + WS_ROPE);
          EpiUpQ E{(const float*)(ws + WS_SSQ), (bf16_t*)(ws + WS_Q), rc, rc + SEQ * 32};
          GEMM_PHASE(10, (GemmDesc{384, 384, 384}), S, E); }
    }
    SEAM(9);
#ifdef NAIVE_ATTN
    if (IN(10)) phase_attn_naive(a, lds);
#else
    if (IN(10)) phase_attn(a, lds);
#endif
    SEAM(10);
    if (IN(11)) {
        SchedDense S{(const bf16_t*)(ws + WS_O), (const bf16_t*)(ws + WS_WO), 1024, 64, 4, G, c, 0, (size_t)256 * 1024};
        EpiWo E{(float*)(ws + WS_X), (bf16_t*)(ws + WS_XB)};
        GEMM_PHASE(11, (GemmDesc{1024, 1024, 1024}), S, E);
    }
    SEAM(11);
    if (IN(12)) phase_route(a, 1, lds);
    SEAM(12);
    if (IN(13)) phase_gather(a, 1, lds);
    SEAM(13);
    if (IN(14)) phase_moe1(a, 1, lds);
    SEAM(14);
    if (IN(15)) phase_moe2(a, 1, lds);
    SEAM(15);
    if (IN(16)) phase_resid<true>(a);
#undef IN
#undef SEAM
}

extern "C" void kernel_launch(void* const* d_in, const int* in_sizes, int n_in, void* d_out, int out_size, void* d_ws, size_t ws_size, hipStream_t stream) {
    static int grid = 0;
    if (grid == 0) {
        if (n_in != 24 || ws_size < WS_END) { fprintf(stderr, "kernel_launch: unexpected n_in %d / ws_size %zu\n", n_in, ws_size); grid = -1; return; }
        int dev = 0, cus = 0;
        if (hipGetDevice(&dev) != hipSuccess || hipDeviceGetAttribute(&cus, hipDeviceAttributeMultiprocessorCount, dev) != hipSuccess || cus <= 0) cus = 256;
        if (hipFuncSetAttribute((const void*)fwd, hipFuncAttributeMaxDynamicSharedMemorySize, LDS_BYTES) != hipSuccess) { fprintf(stderr, "hipFuncSetAttribute failed\n"); grid = -1; return; }
        grid = cus;
    }
    if (grid < 0) return;
    (void)hipMemsetAsync((char*)d_ws + WS_CTL, 0, CTL_ZERO_BYTES, stream);
    Args a{};
    for (int i = 0; i < 24; ++i) a.in[i] = (const float*)d_in[i];
    a.out = (float*)d_out; a.ws = (unsigned char*)d_ws;
#ifndef PROBE_LAST
#define PROBE_LAST 15
#endif
    a.ph_lo = 0; a.ph_hi = NPHASES; a.li = 0; a.pad = 0;
    hipLaunchKernelGGL(fwd, dim3(grid), dim3(NTHREADS), LDS_BYTES, stream, a);
}
```

```cpp
#include <hip/hip_runtime.h>
#include <stdint.h>
#include <stdio.h>
#define NAIVE_MASK 0x0u
#define REPEAT_MASK 0x0u

#define DEVI __device__ __forceinline__
#define LAS __attribute__((address_space(3)))
typedef unsigned short bf16_t;
typedef short bf16x8 __attribute__((ext_vector_type(8)));
typedef float f32x4 __attribute__((ext_vector_type(4)));
typedef float f32x2 __attribute__((ext_vector_type(2)));
typedef unsigned u32x4 __attribute__((ext_vector_type(4)));
typedef unsigned u32x2 __attribute__((ext_vector_type(2)));

constexpr int T_TOK = 16384, SEQ = 8192, DM = 1024;
constexpr int NEXP = 32, DEXP = 512;
constexpr int NH = 8, DQK = 192, DNOPE = 128, DROPE = 64, DV = 128, QRANK = 384, KVRANK = 256;
constexpr float EPS = 1e-6f;
constexpr float QSCALE = 0.10411754627697266f;
constexpr int NWAVES = 8, NTHREADS = 512;
constexpr int LDS_BYTES = 147456, MISC_OFF = 147456 - 64, TS_OFF = 131072;

constexpr size_t MiB = 1u << 20;
constexpr size_t WS_CTL = 0, CTL_ZERO_BYTES = 65536;
constexpr size_t WS_WPOOL = 1 * MiB, WS_WDOWN = 2 * MiB, WS_WUPKV = 4 * MiB, WS_WUPQ = 5 * MiB, WS_WO = 7 * MiB;
constexpr size_t WS_WR = 9 * MiB;
constexpr size_t WS_PBIAS = 9 * MiB + 512 * 1024;
constexpr size_t WS_ROPE = 10 * MiB;
constexpr size_t WS_WH = 12 * MiB;
constexpr size_t WS_CNT = 12 * MiB + 64 * 1024;
constexpr size_t WS_TOKR = 13 * MiB;
constexpr size_t WS_W1 = 16 * MiB, WS_W2 = 144 * MiB;
constexpr size_t WS_X = 208 * MiB, WS_XB = 272 * MiB;
constexpr size_t WS_XG = 304 * MiB, WS_H = 384 * MiB, WS_Y = 424 * MiB;
constexpr size_t WS_PB = 304 * MiB;
constexpr size_t WS_Q = 304 * MiB, WS_KN = 352 * MiB, WS_V = 384 * MiB, WS_O = 416 * MiB;
constexpr size_t WS_CKV = 448 * MiB, WS_CQ = 456 * MiB, WS_KR = 468 * MiB;
constexpr size_t WS_RI = 488 * MiB;
constexpr size_t WS_RS = 489 * MiB;
constexpr size_t WS_RS2 = 489 * MiB + 64 * 1024;
constexpr size_t WS_SSKV = 490 * MiB;
constexpr size_t WS_SSQ = 490 * MiB + 256 * 1024;
constexpr size_t WS_END = 492 * MiB;
constexpr int MAXTILES = 160;

constexpr int CW_CNT = 1024;
constexpr int CW_BAR = 4096;

struct Args { const float* in[24]; float* out; unsigned char* ws; int ph_lo, ph_hi, li, pad; };

typedef __bf16 bf16x2_t __attribute__((ext_vector_type(2)));
DEVI unsigned cvt_pk(float lo, float hi) { const f32x2 v = {lo, hi}; return __builtin_bit_cast(unsigned, __builtin_convertvector(v, bf16x2_t)); }
DEVI float bf2f(unsigned short b) { return __uint_as_float((unsigned)b << 16); }
DEVI float bflo(unsigned w) { return __uint_as_float(w << 16); }
DEVI float bfhi(unsigned w) { return __uint_as_float(w & 0xffff0000u); }
DEVI float wave_sum(float v) {
#pragma unroll
    for (int o = 1; o < 64; o <<= 1) v += __shfl_xor(v, o);
    return v;
}
DEVI float wave_max(float v) {
#pragma unroll
    for (int o = 1; o < 64; o <<= 1) v = fmaxf(v, __shfl_xor(v, o));
    return v;
}
DEVI u32x4 pack8(f32x4 a, f32x4 b) { u32x4 w; w.x = cvt_pk(a[0], a[1]); w.y = cvt_pk(a[2], a[3]); w.z = cvt_pk(b[0], b[1]); w.w = cvt_pk(b[2], b[3]); return w; }

struct Unit { const bf16_t* A; const bf16_t* B; int pm, pn; };
struct GemmDesc { int lda, ldb, K; };

struct SchedDense {
    const bf16_t* A; const bf16_t* B; int lda, nM, nN, G, c; size_t a_pn_off, b_pn_off;
    DEVI bool next(int i, Unit& u) const {
        const int L = i * G + c; if (L >= nM * nN) return false;
        u.pm = L / nN; u.pn = L - u.pm * nN;
        u.A = A + (size_t)u.pm * 256 * lda + (size_t)u.pn * a_pn_off; u.B = B + (size_t)u.pn * b_pn_off; return true;
    }
};
struct SchedMoE {
    const bf16_t* A; const bf16_t* W; const int* tstart; int lda, ldb, NT, G, c;
    DEVI bool next(int i, Unit& u) const {
        const int L = i * G + c; if (L >= NT * 4) return false;
        u.pm = L >> 2; u.pn = L & 3; int e = 0;
        for (int k = 1; k < NEXP; ++k) e += (tstart[k] <= u.pm) ? 1 : 0;
        u.A = A + (size_t)u.pm * 256 * lda; u.B = W + ((size_t)e * 1024 + (size_t)u.pn * 256) * ldb; return true;
    }
};

template <class Epi, class Sched>
DEVI void gemm_phase_naive(const GemmDesc g, const Sched& S, const Epi& E) {
    const int tid = threadIdx.x, wid = __builtin_amdgcn_readfirstlane(tid >> 6), lane = tid & 63, wr = wid >> 2, wc = wid & 3, fr = lane & 15, fq = lane >> 4;
    Unit u;
    for (int i = 0; S.next(i, u); ++i) {
        f32x4 acc[2][2][4][2];
#pragma unroll
        for (int a = 0; a < 2; ++a)
#pragma unroll
            for (int b = 0; b < 2; ++b)
#pragma unroll
                for (int m = 0; m < 4; ++m)
#pragma unroll
                    for (int n = 0; n < 2; ++n) acc[a][b][m][n] = (f32x4){0.f, 0.f, 0.f, 0.f};
        const bf16_t* a0 = u.A + (size_t)(wr * 64 + fr) * g.lda + fq * 8;
        const bf16_t* b0 = u.B + (size_t)(wc * 32 + 8 * (fr >> 2) + (fr & 3)) * g.ldb + fq * 8;
#pragma unroll 1
        for (int k = 0; k < g.K; k += 32) {
            bf16x8 av[2][4], bv[2][2];
#pragma unroll
            for (int ai = 0; ai < 2; ++ai)
#pragma unroll
                for (int m = 0; m < 4; ++m) av[ai][m] = *(const bf16x8*)(a0 + (size_t)(ai * 128 + m * 16) * g.lda + k);
#pragma unroll
            for (int bj = 0; bj < 2; ++bj)
#pragma unroll
                for (int n = 0; n < 2; ++n) bv[bj][n] = *(const bf16x8*)(b0 + (size_t)(bj * 128 + 4 * n) * g.ldb + k);
#pragma unroll
            for (int ai = 0; ai < 2; ++ai)
#pragma unroll
                for (int bj = 0; bj < 2; ++bj)
#pragma unroll
                    for (int m = 0; m < 4; ++m)
#pragma unroll
                        for (int n = 0; n < 2; ++n) acc[ai][bj][m][n] = __builtin_amdgcn_mfma_f32_16x16x32_bf16(bv[bj][n], av[ai][m], acc[ai][bj][m][n], 0, 0, 0);
        }
        E(acc, u, wr, wc, fr, fq);
    }
}

namespace pg8 {
constexpr int BM = 256, BK = 64, HALF = 128, HTB = HALF * BK * 2, STAGE_BYTES = 8 * HTB;
__host__ __device__ __forceinline__ int lds_byte(int r, int c) { const int st = (r >> 4) * 2 + (c >> 5), rr = r & 15, cc = c & 31, ob = rr * 64 + cc * 2; return st * 1024 + (ob ^ (((ob >> 9) & 1) << 5)); }
__host__ __device__ __forceinline__ void stage_rc(int b, int& R, int& C) { const int st = b / 1024, sb = b % 1024, swz = sb ^ (((sb >> 9) & 1) << 5); R = (st >> 1) * 16 + swz / 64; C = (st & 1) * 32 + (swz % 64) / 2; }
__host__ __device__ __forceinline__ int perm32(int rho) { const int n = rho >> 4, i = rho & 15; return 8 * (i >> 2) + 4 * n + (i & 3); }

template <class Epi, class Sched, bool ALIGN_EPI = true, bool SP2 = true>
__device__ __forceinline__ void gemm_phase(LAS unsigned char* lds, const GemmDesc g, const Sched& S, const Epi& E) {
    const int tid = threadIdx.x, wid = __builtin_amdgcn_readfirstlane(tid >> 6), lane = tid & 63, wr = wid >> 2, wc = wid & 3, fr = lane & 15, fq = lane >> 4;
    int K = g.K; asm volatile("" : "+s"(K));
    const int nt = K / BK;
    unsigned voffA[2], voffB[2];
#pragma unroll
    for (int i = 0; i < 2; ++i) { int R, C; stage_rc(tid * 16 + i * 8192, R, C); const int Rb = (R & ~31) + perm32(R & 31);
        voffA[i] = (unsigned)(R * g.lda + C) * 2u; voffB[i] = (unsigned)(Rb * g.ldb + C) * 2u; }
    const size_t kstep = (size_t)(BK * 2);
    const size_t hstepA = (size_t)HALF * g.lda * 2, hstepB = (size_t)HALF * g.ldb * 2;
    const unsigned ldsw = (unsigned)wid * 1024u;
    const int aoff = lds_byte(wr * 64 + fr, fq * 8), boff = lds_byte(wc * 32 + fr, fq * 8);
#define PG8_SA(b, h) (((b) * 2 + (h)) * HTB)
#define PG8_SB(b, h) ((4 + (b) * 2 + (h)) * HTB)
#define PG8_STAGE(bufoff, gbase, voff) do { _Pragma("unroll") for (int _i = 0; _i < 2; ++_i) \
        __builtin_amdgcn_global_load_lds((const unsigned*)((const char*)(gbase) + (voff)[_i]), (LAS unsigned*)(lds + (bufoff) + ldsw + _i * 8192), 16, 0, 0); } while (0)
#define PG8_LDA(dst, b, h) do { _Pragma("unroll") for (int m = 0; m < 4; ++m) _Pragma("unroll") for (int k = 0; k < 2; ++k) dst[m][k] = *(const LAS bf16x8*)(lds + PG8_SA(b, h) + aoff + m * 2048 + k * 1024); } while (0)
#define PG8_LDB(dst, b, h) do { _Pragma("unroll") for (int n = 0; n < 2; ++n) _Pragma("unroll") for (int k = 0; k < 2; ++k) dst[n][k] = *(const LAS bf16x8*)(lds + PG8_SB(b, h) + boff + n * 2048 + k * 1024); } while (0)
#define PG8_MMA(ai, bj, At, Bt) do { __builtin_amdgcn_s_setprio(1); _Pragma("unroll") for (int m = 0; m < 4; ++m) _Pragma("unroll") for (int n = 0; n < 2; ++n) _Pragma("unroll") for (int k = 0; k < 2; ++k) \
        acc[ai][bj][m][n] = __builtin_amdgcn_mfma_f32_16x16x32_bf16(Bt[n][k], At[m][k], acc[ai][bj][m][n], 0, 0, 0); __builtin_amdgcn_s_setprio(0); } while (0)
#define PG8_WAIT_V(n) asm volatile("s_waitcnt vmcnt(" #n ")" ::: "memory")
#define PG8_WAIT_L(n) asm volatile("s_waitcnt lgkmcnt(" #n ")" ::: "memory")
#define PG8_BAR __builtin_amdgcn_s_barrier()
#define PG8_SCHED __builtin_amdgcn_sched_barrier(0)
    Unit cur, nxt; int ui = 0;
    if (!S.next(0, cur)) return;
    f32x4 acc[2][2][4][2];
#pragma unroll
    for (int a = 0; a < 2; ++a)
#pragma unroll
        for (int b = 0; b < 2; ++b)
#pragma unroll
            for (int m = 0; m < 4; ++m)
#pragma unroll
                for (int n = 0; n < 2; ++n) acc[a][b][m][n] = (f32x4){0.f, 0.f, 0.f, 0.f};
    bf16x8 At[4][2], B0[2][2], B1[2][2];
    const char* cA = (const char*)cur.A; const char* cB = (const char*)cur.B;
    if constexpr (SP2) {
        PG8_STAGE(PG8_SB(0, 0), cB, voffB); PG8_STAGE(PG8_SB(0, 1), cB + hstepB, voffB); PG8_STAGE(PG8_SA(0, 0), cA, voffA); PG8_STAGE(PG8_SA(0, 1), cA + hstepA, voffA);
        if (wr == 1) PG8_BAR;
        PG8_WAIT_V(2); PG8_BAR;
        PG8_STAGE(PG8_SB(1, 0), cB + kstep, voffB); PG8_STAGE(PG8_SA(1, 0), cA + kstep, voffA); PG8_STAGE(PG8_SB(1, 1), cB + hstepB + kstep, voffB);
        PG8_WAIT_V(6); PG8_BAR;
    } else {
        PG8_STAGE(PG8_SB(0, 0), cB, voffB); PG8_STAGE(PG8_SA(0, 0), cA, voffA); PG8_STAGE(PG8_SB(0, 1), cB + hstepB, voffB); PG8_STAGE(PG8_SA(0, 1), cA + hstepA, voffA);
        if (wr == 1) PG8_BAR;
        PG8_WAIT_V(4); PG8_BAR;
        PG8_STAGE(PG8_SB(1, 0), cB + kstep, voffB); PG8_STAGE(PG8_SA(1, 0), cA + kstep, voffA); PG8_STAGE(PG8_SB(1, 1), cB + hstepB + kstep, voffB);
        PG8_WAIT_V(6); PG8_BAR;
    }
    for (;;) {
        const bool has_next = S.next(ui + 1, nxt);
        const char* nA = has_next ? (const char*)nxt.A : cA; const char* nB = has_next ? (const char*)nxt.B : cB;
        for (int t = 0; t < nt; t += 2) {
            const bool last = (t == nt - 2);
            const char* a1 = cA + (size_t)(t + 1) * kstep;
            const char* a2 = last ? nA : cA + (size_t)(t + 2) * kstep; const char* b2 = last ? nB : cB + (size_t)(t + 2) * kstep;
            const char* a3 = a2 + kstep; const char* b3 = b2 + kstep;
            if constexpr (SP2) {
            PG8_LDB(B0, 0, 0); PG8_LDB(B1, 0, 1); PG8_SCHED; PG8_LDA(At, 0, 0); PG8_STAGE(PG8_SA(1, 1), a1 + hstepA, voffA);
            PG8_WAIT_V(8); PG8_WAIT_L(0); PG8_BAR; PG8_MMA(0, 0, At, B0); PG8_MMA(0, 1, At, B1); PG8_BAR; PG8_SCHED;
            PG8_LDA(At, 0, 1); PG8_STAGE(PG8_SB(0, 0), b2, voffB); PG8_STAGE(PG8_SB(0, 1), b2 + hstepB, voffB); PG8_STAGE(PG8_SA(0, 0), a2, voffA);
            PG8_WAIT_V(8); PG8_WAIT_L(0); PG8_BAR; PG8_MMA(1, 0, At, B0); PG8_MMA(1, 1, At, B1); PG8_BAR; PG8_SCHED;
            PG8_LDB(B0, 1, 0); PG8_LDB(B1, 1, 1); PG8_SCHED; PG8_LDA(At, 1, 0); PG8_STAGE(PG8_SA(0, 1), a2 + hstepA, voffA);
            PG8_WAIT_V(8); PG8_WAIT_L(0); PG8_BAR; PG8_MMA(0, 0, At, B0); PG8_MMA(0, 1, At, B1); PG8_BAR; PG8_SCHED;
            PG8_LDA(At, 1, 1); PG8_STAGE(PG8_SB(1, 0), b3, voffB); PG8_STAGE(PG8_SB(1, 1), b3 + hstepB, voffB); PG8_STAGE(PG8_SA(1, 0), a3, voffA);
            PG8_WAIT_V(8); PG8_WAIT_L(0); PG8_BAR; PG8_MMA(1, 0, At, B0); PG8_MMA(1, 1, At, B1); PG8_BAR; PG8_SCHED;
            } else {
            PG8_LDB(B0, 0, 0); PG8_SCHED; PG8_LDA(At, 0, 0); PG8_STAGE(PG8_SA(1, 1), a1 + hstepA, voffA);
            PG8_WAIT_L(8); PG8_BAR; PG8_WAIT_L(0); PG8_MMA(0, 0, At, B0); PG8_BAR; PG8_SCHED;
            PG8_LDB(B1, 0, 1); PG8_STAGE(PG8_SB(0, 0), b2, voffB);
            PG8_BAR; PG8_WAIT_L(0); PG8_MMA(0, 1, At, B1); PG8_BAR;
            PG8_LDA(At, 0, 1); PG8_STAGE(PG8_SA(0, 0), a2, voffA);
            PG8_BAR; PG8_WAIT_L(0); PG8_MMA(1, 0, At, B0); PG8_BAR; PG8_SCHED;
            PG8_STAGE(PG8_SB(0, 1), b2 + hstepB, voffB);
            PG8_WAIT_V(6); PG8_BAR; PG8_MMA(1, 1, At, B1); PG8_BAR;
            PG8_LDB(B0, 1, 0); PG8_SCHED; PG8_LDA(At, 1, 0); PG8_STAGE(PG8_SA(0, 1), a2 + hstepA, voffA);
            PG8_WAIT_L(8); PG8_BAR; PG8_WAIT_L(0); PG8_MMA(0, 0, At, B0); PG8_BAR; PG8_SCHED;
            PG8_LDB(B1, 1, 1); PG8_STAGE(PG8_SB(1, 0), b3, voffB);
            PG8_BAR; PG8_WAIT_L(0); PG8_MMA(0, 1, At, B1); PG8_BAR;
            PG8_LDA(At, 1, 1); PG8_STAGE(PG8_SA(1, 0), a3, voffA);
            PG8_BAR; PG8_WAIT_L(0); PG8_MMA(1, 0, At, B0); PG8_BAR; PG8_SCHED;
            PG8_STAGE(PG8_SB(1, 1), b3 + hstepB, voffB);
            PG8_WAIT_V(6); PG8_BAR; PG8_MMA(1, 1, At, B1); PG8_BAR;
            }
        }
        if constexpr (ALIGN_EPI) { if (wr == 0) PG8_BAR; }
        E(acc, cur, wr, wc, fr, fq);
        if (!has_next) break;
#pragma unroll
        for (int a = 0; a < 2; ++a)
#pragma unroll
            for (int b = 0; b < 2; ++b)
#pragma unroll
                for (int m = 0; m < 4; ++m)
#pragma unroll
                    for (int n = 0; n < 2; ++n) acc[a][b][m][n] = (f32x4){0.f, 0.f, 0.f, 0.f};
        cur = nxt; cA = nA; cB = nB; ++ui;
        if constexpr (ALIGN_EPI) { if (wr == 1) PG8_BAR; }
    }
    PG8_WAIT_V(0);
    if constexpr (!ALIGN_EPI) { if (wr == 0) PG8_BAR; }
    PG8_BAR;
#undef PG8_SA
#undef PG8_SB
#undef PG8_STAGE
#undef PG8_LDA
#undef PG8_LDB
#undef PG8_MMA
#undef PG8_WAIT_V
#undef PG8_WAIT_L
#undef PG8_BAR
#undef PG8_SCHED
}
template <class Epi, class Sched, bool ALIGN_EPI = true, bool SP2 = true>
__device__ __forceinline__ void gemm_phase_gather(LAS unsigned char* lds, const GemmDesc g, const Sched& S, const Epi& E, const u32x4* RI) {
    const int tid = threadIdx.x, wid = __builtin_amdgcn_readfirstlane(tid >> 6), lane = tid & 63, wr = wid >> 2, wc = wid & 3, fr = lane & 15, fq = lane >> 4;
    int K = g.K; asm volatile("" : "+s"(K));
    const int nt = K / BK;
    unsigned voffA[2], voffB[2];
#pragma unroll
    for (int i = 0; i < 2; ++i) { int R, C; stage_rc(tid * 16 + i * 8192, R, C); const int Rb = (R & ~31) + perm32(R & 31);
        voffA[i] = (unsigned)(R * g.lda + C) * 2u; voffB[i] = (unsigned)(Rb * g.ldb + C) * 2u; }
    unsigned g0[2][2], g1[2][2], g2[2][2];
    { Unit uu;
#pragma unroll
      for (int i = 0; i < 3; ++i) { const bool ok = S.next(i, uu);
#pragma unroll
        for (int h = 0; h < 2; ++h)
#pragma unroll
            for (int j = 0; j < 2; ++j) { int R, C; stage_rc(tid * 16 + j * 8192, R, C);
                const unsigned tok = ok ? RI[(size_t)uu.pm * 256 + h * 128 + R].w : 0u; const unsigned o = (tok * (unsigned)g.lda + (unsigned)C) * 2u;
                if (i == 0) g0[h][j] = o; else if (i == 1) g1[h][j] = o; else g2[h][j] = o; } } }
    unsigned gc[2][2], gn[2][2];
#pragma unroll
    for (int h = 0; h < 2; ++h)
#pragma unroll
        for (int j = 0; j < 2; ++j) { gc[h][j] = g0[h][j]; gn[h][j] = g1[h][j]; }
    const size_t kstep = (size_t)(BK * 2);
    const size_t hstepA = (size_t)HALF * g.lda * 2, hstepB = (size_t)HALF * g.ldb * 2;
    const unsigned ldsw = (unsigned)wid * 1024u;
    const int aoff = lds_byte(wr * 64 + fr, fq * 8), boff = lds_byte(wc * 32 + fr, fq * 8);
#define PG8_SA(b, h) (((b) * 2 + (h)) * HTB)
#define PG8_SB(b, h) ((4 + (b) * 2 + (h)) * HTB)
#define PG8_STAGE(bufoff, gbase, voff) do { _Pragma("unroll") for (int _i = 0; _i < 2; ++_i) \
        __builtin_amdgcn_global_load_lds((const unsigned*)((const char*)(gbase) + (voff)[_i]), (LAS unsigned*)(lds + (bufoff) + ldsw + _i * 8192), 16, 0, 0); } while (0)
#define PG8_STAGE_A(bufoff, kbase, go) do { _Pragma("unroll") for (int _i = 0; _i < 2; ++_i) \
        __builtin_amdgcn_global_load_lds((const unsigned*)((const char*)(kbase) + (go)[_i]), (LAS unsigned*)(lds + (bufoff) + ldsw + _i * 8192), 16, 0, 0); } while (0)
#define PG8_LDA(dst, b, h) do { _Pragma("unroll") for (int m = 0; m < 4; ++m) _Pragma("unroll") for (int k = 0; k < 2; ++k) dst[m][k] = *(const LAS bf16x8*)(lds + PG8_SA(b, h) + aoff + m * 2048 + k * 1024); } while (0)
#define PG8_LDB(dst, b, h) do { _Pragma("unroll") for (int n = 0; n < 2; ++n) _Pragma("unroll") for (int k = 0; k < 2; ++k) dst[n][k] = *(const LAS bf16x8*)(lds + PG8_SB(b, h) + boff + n * 2048 + k * 1024); } while (0)
#define PG8_MMA(ai, bj, At, Bt) do { __builtin_amdgcn_s_setprio(1); _Pragma("unroll") for (int m = 0; m < 4; ++m) _Pragma("unroll") for (int n = 0; n < 2; ++n) _Pragma("unroll") for (int k = 0; k < 2; ++k) \
        acc[ai][bj][m][n] = __builtin_amdgcn_mfma_f32_16x16x32_bf16(Bt[n][k], At[m][k], acc[ai][bj][m][n], 0, 0, 0); __builtin_amdgcn_s_setprio(0); } while (0)
#define PG8_WAIT_V(n) asm volatile("s_waitcnt vmcnt(" #n ")" ::: "memory")
#define PG8_WAIT_L(n) asm volatile("s_waitcnt lgkmcnt(" #n ")" ::: "memory")
#define PG8_BAR __builtin_amdgcn_s_barrier()
#define PG8_SCHED __builtin_amdgcn_sched_barrier(0)
    Unit cur, nxt; int ui = 0;
    if (!S.next(0, cur)) return;
    f32x4 acc[2][2][4][2];
#pragma unroll
    for (int a = 0; a < 2; ++a)
#pragma unroll
        for (int b = 0; b < 2; ++b)
#pragma unroll
            for (int m = 0; m < 4; ++m)
#pragma unroll
                for (int n = 0; n < 2; ++n) acc[a][b][m][n] = (f32x4){0.f, 0.f, 0.f, 0.f};
    bf16x8 At[4][2], B0[2][2], B1[2][2];
    const char* cA = (const char*)cur.A; const char* cB = (const char*)cur.B;
    if constexpr (SP2) {
        PG8_STAGE(PG8_SB(0, 0), cB, voffB); PG8_STAGE(PG8_SB(0, 1), cB + hstepB, voffB); PG8_STAGE_A(PG8_SA(0, 0), cA, gc[0]); PG8_STAGE_A(PG8_SA(0, 1), cA, gc[1]);
        if (wr == 1) PG8_BAR;
        PG8_WAIT_V(2); PG8_BAR;
        PG8_STAGE(PG8_SB(1, 0), cB + kstep, voffB); PG8_STAGE_A(PG8_SA(1, 0), cA + kstep, gc[0]); PG8_STAGE(PG8_SB(1, 1), cB + hstepB + kstep, voffB);
        PG8_WAIT_V(6); PG8_BAR;
    } else {
        PG8_STAGE(PG8_SB(0, 0), cB, voffB); PG8_STAGE_A(PG8_SA(0, 0), cA, gc[0]); PG8_STAGE(PG8_SB(0, 1), cB + hstepB, voffB); PG8_STAGE_A(PG8_SA(0, 1), cA, gc[1]);
        if (wr == 1) PG8_BAR;
        PG8_WAIT_V(4); PG8_BAR;
        PG8_STAGE(PG8_SB(1, 0), cB + kstep, voffB); PG8_STAGE_A(PG8_SA(1, 0), cA + kstep, gc[0]); PG8_STAGE(PG8_SB(1, 1), cB + hstepB + kstep, voffB);
        PG8_WAIT_V(6); PG8_BAR;
    }
    for (;;) {
        const bool has_next = S.next(ui + 1, nxt);
        const char* nA = has_next ? (const char*)nxt.A : cA; const char* nB = has_next ? (const char*)nxt.B : cB;
        for (int t = 0; t < nt; t += 2) {
            const bool last = (t == nt - 2);
            const char* a1 = cA + (size_t)(t + 1) * kstep;
            const char* a2 = last ? cA : cA + (size_t)(t + 2) * kstep; const char* b2 = last ? nB : cB + (size_t)(t + 2) * kstep;
            const char* a3 = a2 + kstep; const char* b3 = b2 + kstep;
            unsigned gx[2][2];
#pragma unroll
            for (int h = 0; h < 2; ++h)
#pragma unroll
                for (int j = 0; j < 2; ++j) gx[h][j] = last ? gn[h][j] : gc[h][j];
            if constexpr (SP2) {
            PG8_LDB(B0, 0, 0); PG8_LDB(B1, 0, 1); PG8_SCHED; PG8_LDA(At, 0, 0); PG8_STAGE_A(PG8_SA(1, 1), a1, gc[1]);
            PG8_WAIT_V(8); PG8_WAIT_L(0); PG8_BAR; PG8_MMA(0, 0, At, B0); PG8_MMA(0, 1, At, B1); PG8_BAR; PG8_SCHED;
            PG8_LDA(At, 0, 1); PG8_STAGE(PG8_SB(0, 0), b2, voffB); PG8_STAGE(PG8_SB(0, 1), b2 + hstepB, voffB); PG8_STAGE_A(PG8_SA(0, 0), a2, gx[0]);
            PG8_WAIT_V(8); PG8_WAIT_L(0); PG8_BAR; PG8_MMA(1, 0, At, B0); PG8_MMA(1, 1, At, B1); PG8_BAR; PG8_SCHED;
            PG8_LDB(B0, 1, 0); PG8_LDB(B1, 1, 1); PG8_SCHED; PG8_LDA(At, 1, 0); PG8_STAGE_A(PG8_SA(0, 1), a2, gx[1]);
            PG8_WAIT_V(8); PG8_WAIT_L(0); PG8_BAR; PG8_MMA(0, 0, At, B0); PG8_MMA(0, 1, At, B1); PG8_BAR; PG8_SCHED;
            PG8_LDA(At, 1, 1); PG8_STAGE(PG8_SB(1, 0), b3, voffB); PG8_STAGE(PG8_SB(1, 1), b3 + hstepB, voffB); PG8_STAGE_A(PG8_SA(1, 0), a3, gx[0]);
            PG8_WAIT_V(8); PG8_WAIT_L(0); PG8_BAR; PG8_MMA(1, 0, At, B0); PG8_MMA(1, 1, At, B1); PG8_BAR; PG8_SCHED;
            } else {
            PG8_LDB(B0, 0, 0); PG8_SCHED; PG8_LDA(At, 0, 0); PG8_STAGE_A(PG8_SA(1, 1), a1, gc[1]);
            PG8_WAIT_L(8); PG8_BAR; PG8_WAIT_L(0); PG8_MMA(0, 0, At, B0); PG8_BAR; PG8_SCHED;
            PG8_LDB(B1, 0, 1); PG8_STAGE(PG8_SB(0, 0), b2, voffB);
            PG8_BAR; PG8_WAIT_L(0); PG8_MMA(0, 1, At, B1); PG8_BAR;
            PG8_LDA(At, 0, 1); PG8_STAGE_A(PG8_SA(0, 0), a2, gx[0]);
            PG8_BAR; PG8_WAIT_L(0); PG8_MMA(1, 0, At, B0); PG8_BAR; PG8_SCHED;
            PG8_STAGE(PG8_SB(0, 1), b2 + hstepB, voffB);
            PG8_WAIT_V(6); PG8_BAR; PG8_MMA(1, 1, At, B1); PG8_BAR;
            PG8_LDB(B0, 1, 0); PG8_SCHED; PG8_LDA(At, 1, 0); PG8_STAGE_A(PG8_SA(0, 1), a2, gx[1]);
            PG8_WAIT_L(8); PG8_BAR; PG8_WAIT_L(0); PG8_MMA(0, 0, At, B0); PG8_BAR; PG8_SCHED;
            PG8_LDB(B1, 1, 1); PG8_STAGE(PG8_SB(1, 0), b3, voffB);
            PG8_BAR; PG8_WAIT_L(0); PG8_MMA(0, 1, At, B1); PG8_BAR;
            PG8_LDA(At, 1, 1); PG8_STAGE_A(PG8_SA(1, 0), a3, gx[0]);
            PG8_BAR; PG8_WAIT_L(0); PG8_MMA(1, 0, At, B0); PG8_BAR; PG8_SCHED;
            PG8_STAGE(PG8_SB(1, 1), b3 + hstepB, voffB);
            PG8_WAIT_V(6); PG8_BAR; PG8_MMA(1, 1, At, B1); PG8_BAR;
            }
        }
        if constexpr (ALIGN_EPI) { if (wr == 0) PG8_BAR; }
        E(acc, cur, wr, wc, fr, fq);
        if (!has_next) break;
#pragma unroll
        for (int a = 0; a < 2; ++a)
#pragma unroll
            for (int b = 0; b < 2; ++b)
#pragma unroll
                for (int m = 0; m < 4; ++m)
#pragma unroll
                    for (int n = 0; n < 2; ++n) acc[a][b][m][n] = (f32x4){0.f, 0.f, 0.f, 0.f};
        cur = nxt; cB = nB; ++ui;
#pragma unroll
        for (int h = 0; h < 2; ++h)
#pragma unroll
            for (int j = 0; j < 2; ++j) { gc[h][j] = gn[h][j]; gn[h][j] = g2[h][j]; }
        if constexpr (ALIGN_EPI) { if (wr == 1) PG8_BAR; }
    }
    PG8_WAIT_V(0);
    if constexpr (!ALIGN_EPI) { if (wr == 0) PG8_BAR; }
    PG8_BAR;
#undef PG8_SA
#undef PG8_SB
#undef PG8_STAGE
#undef PG8_STAGE_A
#undef PG8_LDA
#undef PG8_LDB
#undef PG8_MMA
#undef PG8_WAIT_V
#undef PG8_WAIT_L
#undef PG8_BAR
#undef PG8_SCHED
}
}

#ifndef NAIVE_MASK
#define NAIVE_MASK 0u
#endif
#define GEMM_PHASE(ph, g, S, E) do { if ((NAIVE_MASK >> (ph)) & 1u) gemm_phase_naive(g, S, E); else pg8::gemm_phase((LAS unsigned char*)lds, g, S, E); } while (0)
DEVI void opaque(unsigned& x) { asm volatile("" : "+v"(x)); }
#define EPI_ROWS_BEGIN(r0) { unsigned row_ = (r0); _Pragma("unroll") for (int ai = 0; ai < 2; ++ai) { _Pragma("unroll") for (int m = 0; m < 4; ++m) { opaque(row_); const unsigned row = row_;
#define EPI_ROWS_END row_ += 16u; } row_ += 64u; } }

struct EpiPool {
    const float* xin; const float* bias; float* X; bf16_t* XB;
    DEVI void operator()(const f32x4 (&acc)[2][2][4][2], const Unit& u, int wr, int wc, int fr, int fq) const {
        const unsigned col0 = u.pn * 256 + wc * 32 + 8 * fq;
        f32x4 bv[2][2];
#pragma unroll
        for (int bj = 0; bj < 2; ++bj) { bv[bj][0] = *(const f32x4*)(bias + col0 + bj * 128); bv[bj][1] = *(const f32x4*)(bias + col0 + bj * 128 + 4); }
#pragma unroll
        for (int ai = 0; ai < 2; ++ai) {
            f32x4 xv[4][2][2];
            unsigned off = (u.pm * 256 + wr * 64 + fr + ai * 128) * DM + col0;
#pragma unroll
            for (int m = 0; m < 4; ++m) { opaque(off);
#pragma unroll
                for (int bj = 0; bj < 2; ++bj) { xv[m][bj][0] = *(const f32x4*)(xin + off + bj * 128); xv[m][bj][1] = *(const f32x4*)(xin + off + bj * 128 + 4); }
                off += 16 * DM; }
            off -= 64 * DM;
#pragma unroll
            for (int m = 0; m < 4; ++m) { opaque(off);
#pragma unroll
                for (int bj = 0; bj < 2; ++bj) {
                    const unsigned o = off + bj * 128;
                    const f32x4 v0 = acc[ai][bj][m][0] + bv[bj][0] + xv[m][bj][0], v1 = acc[ai][bj][m][1] + bv[bj][1] + xv[m][bj][1];
                    *(f32x4*)(X + o) = v0; *(f32x4*)(X + o + 4) = v1;
                    *(u32x4*)(XB + o) = pack8(v0, v1);
                }
                off += 16 * DM; }
        }
    }
};
struct EpiSwiGLU {
    const u32x4* RI; bf16_t* H;
    DEVI void operator()(const f32x4 (&acc)[2][2][4][2], const Unit& u, int wr, int wc, int fr, int fq) const {
        const unsigned col0 = (u.pn * 256 + wc * 32 + 8 * fq) >> 1;
        float rsv[2][4];
        EPI_ROWS_BEGIN(u.pm * 256 + wr * 64 + fr)
            rsv[ai][m] = __uint_as_float(RI[row].z);
        EPI_ROWS_END
        EPI_ROWS_BEGIN(u.pm * 256 + wr * 64 + fr)
            const float rstd = rsv[ai][m];
#pragma unroll
            for (int bj = 0; bj < 2; ++bj) {
                const f32x4 gv = acc[ai][bj][m][0] * rstd, uv = acc[ai][bj][m][1] * rstd;
                float h[4];
#pragma unroll
                for (int j = 0; j < 4; ++j) h[j] = gv[j] / (1.f + __expf(-gv[j])) * uv[j];
                u32x2 w; w.x = cvt_pk(h[0], h[1]); w.y = cvt_pk(h[2], h[3]);
                *(u32x2*)(H + row * DEXP + col0 + bj * 64) = w;
            }
        EPI_ROWS_END
    }
};
struct EpiMoeDown {
    const u32x4* RI; bf16_t* Y;
    DEVI void operator()(const f32x4 (&acc)[2][2][4][2], const Unit& u, int wr, int wc, int fr, int fq) const {
        const unsigned col0 = u.pn * 256 + wc * 32 + 8 * fq;
        u32x2 riv[2][4];
        EPI_ROWS_BEGIN(u.pm * 256 + wr * 64 + fr)
            riv[ai][m] = *(const u32x2*)(RI + row);
        EPI_ROWS_END
        EPI_ROWS_BEGIN(u.pm * 256 + wr * 64 + fr)
            const int dest = (int)riv[ai][m].x; const float w = __uint_as_float(riv[ai][m].y);
            if (dest >= 0) {
                const unsigned o = ((unsigned)(dest & 1) * T_TOK + (unsigned)(dest >> 1)) * DM + col0;
#pragma unroll
                for (int bj = 0; bj < 2; ++bj) *(u32x4*)(Y + o + bj * 128) = pack8(acc[ai][bj][m][0] * w, acc[ai][bj][m][1] * w);
            }
        EPI_ROWS_END
    }
};
DEVI float sumsq8(f32x4 a, f32x4 b) { return ((a[0] * a[0] + a[1] * a[1]) + (a[2] * a[2] + a[3] * a[3])) + ((b[0] * b[0] + b[1] * b[1]) + (b[2] * b[2] + b[3] * b[3])); }
DEVI void rope4(f32x4 v0, f32x4 v1, f32x4 c, f32x4 s, u32x2& w1, u32x2& w2) {
    const float a1[4] = {v0[0], v0[2], v1[0], v1[2]}, a2[4] = {v0[1], v0[3], v1[1], v1[3]};
    float o1[4], o2[4];
#pragma unroll
    for (int j = 0; j < 4; ++j) { o1[j] = a1[j] * c[j] - a2[j] * s[j]; o2[j] = a2[j] * c[j] + a1[j] * s[j]; }
    w1.x = cvt_pk(o1[0], o1[1]); w1.y = cvt_pk(o1[2], o1[3]); w2.x = cvt_pk(o2[0], o2[1]); w2.y = cvt_pk(o2[2], o2[3]);
}
struct EpiDownProj {
    const float* RS2; bf16_t* CKV; bf16_t* CQ; bf16_t* KR; float* SSKV; float* SSQ; const float* ropec; const float* ropes;
    DEVI void operator()(const f32x4 (&acc)[2][2][4][2], const Unit& u, int wr, int wc, int fr, int fq) const {
        const unsigned colw = wc * 32 + 8 * fq;
        float rsv[2][4];
        EPI_ROWS_BEGIN(u.pm * 256 + wr * 64 + fr)
            rsv[ai][m] = RS2[row];
        EPI_ROWS_END
        EPI_ROWS_BEGIN(u.pm * 256 + wr * 64 + fr)
            const float rstd = rsv[ai][m];
            float ss = 0.f;
#pragma unroll
            for (int bj = 0; bj < 2; ++bj) {
                const unsigned col = bj * 128 + colw;
                const f32x4 v0 = acc[ai][bj][m][0] * rstd, v1 = acc[ai][bj][m][1] * rstd;
                if (u.pn == 0) { ss += sumsq8(v0, v1); *(u32x4*)(CKV + row * KVRANK + col) = pack8(v0, v1); }
                else if (u.pn == 1 && col < 64) {
                    const unsigned i0 = col >> 1, pos = row & (SEQ - 1);
                    const f32x4 c = *(const f32x4*)(ropec + pos * 32 + i0), s = *(const f32x4*)(ropes + pos * 32 + i0);
                    u32x2 w1, w2; rope4(v0, v1, c, s, w1, w2);
                    *(u32x2*)(KR + row * DROPE + i0) = w1; *(u32x2*)(KR + row * DROPE + 32 + i0) = w2;
                } else {
                    const unsigned cq = u.pn * 256 + col - 320;
                    if (cq < (unsigned)QRANK) { ss += sumsq8(v0, v1); *(u32x4*)(CQ + row * QRANK + cq) = pack8(v0, v1); }
                }
            }
            ss += __shfl_xor(ss, 16); ss += __shfl_xor(ss, 32);
            if (fq == 0) { if (u.pn == 0) SSKV[row * 4 + wc] = ss; else SSQ[row * 8 + (u.pn - 1) * 4 + wc] = ss; }
        EPI_ROWS_END
    }
};
struct EpiUpKV {
    const float* SSKV; bf16_t* KN; bf16_t* V;
    DEVI void operator()(const f32x4 (&acc)[2][2][4][2], const Unit& u, int wr, int wc, int fr, int fq) const {
        bf16_t* base = (u.pn < 4) ? KN : V;
        const unsigned h0 = (u.pn & 3) * 2, d = wc * 32 + 8 * fq;
        float rsv[2][4];
        EPI_ROWS_BEGIN(u.pm * 256 + wr * 64 + fr)
            const f32x4 sp = *(const f32x4*)(SSKV + row * 4);
            rsv[ai][m] = ((sp[0] + sp[1]) + (sp[2] + sp[3]));
        EPI_ROWS_END
        EPI_ROWS_BEGIN(u.pm * 256 + wr * 64 + fr)
            const float rstd = rsqrtf(rsv[ai][m] * (1.f / KVRANK) + EPS);
            const unsigned b = row >> 13, s = row & (SEQ - 1);
#pragma unroll
            for (int bj = 0; bj < 2; ++bj)
                *(u32x4*)(base + (((b * NH + h0 + bj) * SEQ + s) * 128 + d)) = pack8(acc[ai][bj][m][0] * rstd, acc[ai][bj][m][1] * rstd);
        EPI_ROWS_END
    }
};
struct EpiUpQ {
    const float* SSQ; bf16_t* Q; const float* ropec; const float* ropes;
    DEVI void operator()(const f32x4 (&acc)[2][2][4][2], const Unit& u, int wr, int wc, int fr, int fq) const {
        unsigned hh[2], jj[2];
#pragma unroll
        for (int bj = 0; bj < 2; ++bj) { const unsigned n = u.pn * 256 + bj * 128 + wc * 32 + 8 * fq; hh[bj] = n / DQK; jj[bj] = n - hh[bj] * DQK; }
        float rsv[2][4];
        EPI_ROWS_BEGIN(u.pm * 256 + wr * 64 + fr)
            const f32x4 sa = *(const f32x4*)(SSQ + row * 8), sb = *(const f32x4*)(SSQ + row * 8 + 4);
            rsv[ai][m] = (((sa[0] + sa[1]) + (sa[2] + sa[3])) + ((sb[0] + sb[1]) + (sb[2] + sb[3])));
        EPI_ROWS_END
        EPI_ROWS_BEGIN(u.pm * 256 + wr * 64 + fr)
            const float rstd = rsqrtf(rsv[ai][m] * (1.f / QRANK) + EPS);
            const unsigned b = row >> 13, s = row & (SEQ - 1);
#pragma unroll
            for (int bj = 0; bj < 2; ++bj) {
                bf16_t* qrow = Q + ((b * NH + hh[bj]) * SEQ + s) * DQK;
                const f32x4 v0 = acc[ai][bj][m][0] * rstd, v1 = acc[ai][bj][m][1] * rstd;
                if (jj[bj] < (unsigned)DNOPE) { *(u32x4*)(qrow + jj[bj]) = pack8(v0, v1); }
                else {
                    const unsigned i0 = (jj[bj] - DNOPE) >> 1;
                    const f32x4 c = *(const f32x4*)(ropec + s * 32 + i0), sn = *(const f32x4*)(ropes + s * 32 + i0);
                    u32x2 w1, w2; rope4(v0, v1, c, sn, w1, w2);
                    *(u32x2*)(qrow + DNOPE + i0) = w1; *(u32x2*)(qrow + DNOPE + 32 + i0) = w2;
                }
            }
        EPI_ROWS_END
    }
};
struct EpiWo {
    float* X; bf16_t* XB;
    DEVI void operator()(const f32x4 (&acc)[2][2][4][2], const Unit& u, int wr, int wc, int fr, int fq) const {
        const unsigned col0 = u.pn * 256 + wc * 32 + 8 * fq;
#pragma unroll
        for (int ai = 0; ai < 2; ++ai) {
            f32x4 xv[4][2][2];
            unsigned off = (u.pm * 256 + wr * 64 + fr + ai * 128) * DM + col0;
#pragma unroll
            for (int m = 0; m < 4; ++m) { opaque(off);
#pragma unroll
                for (int bj = 0; bj < 2; ++bj) { xv[m][bj][0] = *(const f32x4*)(X + off + bj * 128); xv[m][bj][1] = *(const f32x4*)(X + off + bj * 128 + 4); }
                off += 16 * DM; }
            off -= 64 * DM;
            asm volatile("" ::: "memory");
#pragma unroll
            for (int m = 0; m < 4; ++m) { opaque(off);
#pragma unroll
                for (int bj = 0; bj < 2; ++bj) {
                    const unsigned o = off + bj * 128;
                    const f32x4 v0 = xv[m][bj][0] + acc[ai][bj][m][0], v1 = xv[m][bj][1] + acc[ai][bj][m][1];
                    *(f32x4*)(X + o) = v0; *(f32x4*)(X + o + 4) = v1;
                    *(u32x4*)(XB + o) = pack8(v0, v1);
                }
                off += 16 * DM; }
        }
    }
};

struct ConvJob { const float* src; const float* gain; const float* cvec; bf16_t* dst; int ldsrc, lddst, k0, n0, width, map, mparam; float cscale; };
DEVI int dst_row(int map, int mparam, int n) {
    if (map == 0) return n + mparam;
    if (map == 1) return 8 * (n >> 2) + (n & 3) + mparam;
    if (map == 3) { const int p = n - 256; return 256 + 2 * (p & 31) + (p >> 5); }
    const int h = n / DQK, j = n - h * DQK; if (j < DNOPE) return n; const int p = j - DNOPE; return h * DQK + DNOPE + 2 * (p & 31) + (p >> 5);
}
constexpr int NCONV_EXP = 64 * 96, NCONV_SMALL = 212, NCONV = NCONV_EXP + NCONV_SMALL;
DEVI void conv_decode(const Args& a, int t, ConvJob& j) {
    unsigned char* ws = a.ws;
    j.gain = nullptr; j.cvec = nullptr; j.cscale = 1.f; j.width = 256; j.map = 0; j.mparam = 0;
    if (t < NCONV_EXP) {
        const int le = t / 96, r = t - le * 96, l = le >> 5;
        if (r < 64) { const int rr = r & 31, up = r >> 5; j.src = a.in[up ? 21 : 20] + (size_t)le * 1024 * 512; j.ldsrc = 512; j.k0 = (rr >> 1) * 64; j.n0 = (rr & 1) * 256;
            j.gain = a.in[15] + l * 1024; j.dst = (bf16_t*)(ws + WS_W1) + (size_t)le * 1024 * 1024; j.lddst = 1024; j.map = 1; j.mparam = up ? 4 : 0; }
        else { const int rr = r - 64; j.src = a.in[22] + (size_t)le * 512 * 1024; j.ldsrc = 1024; j.k0 = (rr >> 2) * 64; j.n0 = (rr & 3) * 256;
            j.dst = (bf16_t*)(ws + WS_W2) + (size_t)le * 1024 * 512; j.lddst = 512; }
        return;
    }
    t -= NCONV_EXP;
    if (t < 16) { const int g = t >> 2; j.src = a.in[2] + g * 65536; j.ldsrc = 256; j.k0 = (t & 3) * 64; j.n0 = 0; j.gain = a.in[1] + g * 256; j.cvec = a.in[4] + g * 256;
        j.dst = (bf16_t*)(ws + WS_WPOOL) + g * 65536; j.lddst = 256; return; }
    t -= 16;
    if (t < 32) { const int nt = t & 1; j.src = a.in[6]; j.ldsrc = 320; j.k0 = (t >> 1) * 64; j.n0 = nt * 256; j.width = nt ? 64 : 256; j.gain = a.in[5];
        j.dst = (bf16_t*)(ws + WS_WDOWN); j.lddst = 1024; j.map = nt ? 3 : 0; return; }
    t -= 32;
    if (t < 32) { const int nt = t & 1; j.src = a.in[11]; j.ldsrc = 384; j.k0 = (t >> 1) * 64; j.n0 = nt * 256; j.width = nt ? 128 : 256; j.gain = a.in[10];
        j.dst = (bf16_t*)(ws + WS_WDOWN); j.lddst = 1024; j.mparam = 320; return; }
    t -= 32;
    if (t < 32) { const int uv = t >> 4, tt = t & 15; j.src = a.in[uv ? 9 : 8]; j.ldsrc = 1024; j.k0 = (tt >> 2) * 64; j.n0 = (tt & 3) * 256; j.gain = a.in[7];
        j.dst = (bf16_t*)(ws + WS_WUPKV); j.lddst = 256; j.mparam = uv ? 1024 : 0; return; }
    t -= 32;
    if (t < 36) { j.src = a.in[13]; j.ldsrc = 1536; j.k0 = (t / 6) * 64; j.n0 = (t % 6) * 256; j.gain = a.in[12]; j.cscale = QSCALE;
        j.dst = (bf16_t*)(ws + WS_WUPQ); j.lddst = 384; j.map = 4; return; }
    t -= 36;
    j.src = a.in[14]; j.ldsrc = 1024; j.k0 = (t >> 2) * 64; j.n0 = (t & 3) * 256; j.dst = (bf16_t*)(ws + WS_WO); j.lddst = 1024;
}
DEVI void conv_tile(const ConvJob& j, float* tile) {
    const int tid = threadIdx.x, w = tid >> 6, lane = tid & 63, n4 = lane * 4;
    if (n4 < j.width) {
#pragma unroll
        for (int i = 0; i < 8; ++i) { const int k = w + 8 * i;
            f32x4 v = *(const f32x4*)(j.src + (size_t)(j.k0 + k) * j.ldsrc + j.n0 + n4);
            const float g = j.gain ? j.gain[j.k0 + k] : 1.f;
            float* tp = tile + k * 257 + n4; tp[0] = v[0] * g; tp[1] = v[1] * g; tp[2] = v[2] * g; tp[3] = v[3] * g; }
    }
    __syncthreads();
#pragma unroll
    for (int i = 0; i < 4; ++i) { const int q = tid + 512 * i, kp = q & 7, nl = q >> 3;
        if (nl < j.width) {
            const float cs = j.cscale * (j.cvec ? j.cvec[j.n0 + nl] : 1.f);
            const float* tp = tile + (8 * kp) * 257 + nl;
            u32x4 o; o.x = cvt_pk(tp[0] * cs, tp[257] * cs); o.y = cvt_pk(tp[2 * 257] * cs, tp[3 * 257] * cs); o.z = cvt_pk(tp[4 * 257] * cs, tp[5 * 257] * cs); o.w = cvt_pk(tp[6 * 257] * cs, tp[7 * 257] * cs);
            const int row = dst_row(j.map, j.mparam, j.n0 + nl);
            *(u32x4*)(j.dst + (size_t)row * j.lddst + j.k0 + 8 * kp) = o;
        }
    }
    __syncthreads();
}
__device__ const double ROPE_THETA_TAB[32] = {1.0, 0.7498942093324559, 0.5623413251903491, 0.4216965034285822, 0.31622776601683794, 0.23713737056616552, 0.1778279410038923, 0.1333521432163324, 0.1, 0.07498942093324558, 0.05623413251903491, 0.042169650342858224, 0.03162277660168379, 0.023713737056616554, 0.01778279410038923, 0.01333521432163324, 0.01, 0.007498942093324558, 0.005623413251903491, 0.004216965034285823, 0.0031622776601683794, 0.0023713737056616554, 0.0017782794100389228, 0.001333521432163324, 0.001, 0.0007498942093324559, 0.0005623413251903491, 0.00042169650342858224, 0.00031622776601683794, 0.00023713737056616554, 0.00017782794100389227, 0.0001333521432163324};
DEVI void sincos_d(double a, float& sn, float& cs) {
    const double t = a * 0.15915494309189535;
    const double fr = t - __builtin_rint(t);
    const double q = __builtin_rint(fr * 4.0);
    const double y = (fr - q * 0.25) * 6.283185307179586;
    const double y2 = y * y;
    double s = y * (1.0 + y2 * (-1.0 / 6 + y2 * (1.0 / 120 + y2 * (-1.0 / 5040 + y2 * (1.0 / 362880 + y2 * (-1.0 / 39916800 + y2 * (1.0 / 6227020800.0)))))));
    double c = 1.0 + y2 * (-0.5 + y2 * (1.0 / 24 + y2 * (-1.0 / 720 + y2 * (1.0 / 40320 + y2 * (-1.0 / 3628800 + y2 * (1.0 / 479001600.0))))));
    const int qi = ((int)q) & 3;
    double so, co;
    if (qi == 0) { so = s; co = c; } else if (qi == 1) { so = c; co = -s; } else if (qi == 2) { so = -s; co = -c; } else { so = -c; co = s; }
    sn = (float)so; cs = (float)co;
}
DEVI void phase_prologue(const Args& a, unsigned char* lds) {
    float* tile = (float*)lds;
    for (int t = blockIdx.x; t < NCONV; t += gridDim.x) { ConvJob j; conv_decode(a, t, j); conv_tile(j, tile); }
    const int gtid = blockIdx.x * NTHREADS + threadIdx.x, gn = gridDim.x * NTHREADS;
    unsigned char* ws = a.ws;
    { u32x4* z = (u32x4*)((bf16_t*)(ws + WS_WDOWN) + 704 * 1024); for (int i = gtid; i < 64 * 1024 * 2 / 16; i += gn) z[i] = (u32x4){0u, 0u, 0u, 0u}; }
    { float* wr = (float*)(ws + WS_WR);
      for (int i = gtid; i < 2 * 36 * 1024; i += gn) { const int l = i / (36 * 1024), r = i - l * 36 * 1024, jj = r >> 10, k = r & 1023;
          const float g = a.in[15][l * 1024 + k];
          wr[i] = g * (jj < 4 ? a.in[16][(size_t)(l * 1024 + k) * 4 + jj] : a.in[18][(size_t)(l * 1024 + k) * 32 + (jj - 4)]); } }
    { float* pb = (float*)(ws + WS_PBIAS); for (int i = gtid; i < 1024; i += gn) pb[i] = a.in[3][i] * a.in[4][i]; }
    { float* rc = (float*)(ws + WS_ROPE); float* rs = rc + SEQ * 32;
      for (int i = gtid; i < SEQ * 32; i += gn) { const int pos = i >> 5, k = i & 31; const float th = (float)ROPE_THETA_TAB[k]; const float ang = (float)pos * th;
          float sn, cs; sincos_d((double)ang, sn, cs); rc[i] = cs; rs[i] = sn; } }
}

template <int WIN>
DEVI void pool_channel(const float* xc, int pos0, const float* rstd, bf16_t* outc) {
    float ring[16];
#pragma unroll
    for (int u = 0; u < 16; ++u) ring[u] = 0.f;
    float P = 0.f;
    for (int blk = 0; blk < 5; ++blk) {
#pragma unroll
        for (int u = 0; u < 16; ++u) {
            const int rr = blk * 16 + u;
            if (rr < 79) {
                const int pos = pos0 - 15 + rr;
                const float v = (pos >= 0) ? xc[(long)pos * DM] * rstd[rr] : 0.f;
                P += v;
                const float Pold = ring[(u - WIN) & 15];
                ring[u] = P;
                if (rr >= 15) { const int cnt = (pos + 1 < WIN) ? pos + 1 : WIN; const float mean = (P - Pold) / (float)cnt;
                    outc[(long)(rr - 15) * DM] = (bf16_t)(cvt_pk(mean - v, 0.f) & 0xffffu); }
            }
        }
    }
}
DEVI void phase_pool_prep(const Args& a, unsigned char* lds) {
    const float* x = a.in[0]; bf16_t* PB = (bf16_t*)(a.ws + WS_PB);
    float* rstd = (float*)lds;
    const int tid = threadIdx.x, wid = tid >> 6, lane = tid & 63;
    for (int c = blockIdx.x; c < T_TOK / 64; c += gridDim.x) {
        const int b = c >> 7, pos0 = (c & 127) * 64;
        const float* xb = x + (size_t)b * SEQ * DM;
        for (int rr = wid; rr < 79; rr += NWAVES) {
            const int pos = pos0 - 15 + rr; float r = 0.f;
            if (pos >= 0) { const f32x4* xr = (const f32x4*)(xb + (size_t)pos * DM) + lane; float s = 0.f;
#pragma unroll
                for (int j = 0; j < 4; ++j) { const f32x4 v = xr[64 * j]; s += (v[0] * v[0] + v[1] * v[1]) + (v[2] * v[2] + v[3] * v[3]); }
                r = rsqrtf(wave_sum(s) * (1.f / DM) + EPS); }
            if (lane == 0) rstd[rr] = r;
        }
        __syncthreads();
#pragma unroll
        for (int pass = 0; pass < 2; ++pass) {
            const int ch = tid + 512 * pass, g = __builtin_amdgcn_readfirstlane(ch >> 8);
            const float* xc = xb + ch; bf16_t* oc = PB + ((size_t)b * SEQ + pos0) * DM + ch;
            if (g == 0) pool_channel<2>(xc, pos0, rstd, oc); else if (g == 1) pool_channel<4>(xc, pos0, rstd, oc);
            else if (g == 2) pool_channel<8>(xc, pos0, rstd, oc); else pool_channel<16>(xc, pos0, rstd, oc);
        }
        __syncthreads();
    }
}

DEVI void phase_route(const Args& a, int layer, unsigned char* lds) {
    const float* X = (const float*)(a.ws + WS_X);
    const float* Wr = (const float*)(a.ws + WS_WR) + layer * 36 * 1024;
    const float* bg = a.in[17] + layer * 4; const float* be = a.in[19] + layer * 32;
    unsigned* WH = (unsigned*)(a.ws + WS_WH);
    u32x4* TOKR = (u32x4*)(a.ws + WS_TOKR);
    float* part = (float*)lds;
    float* lg = (float*)(lds + 16384);
    int* ea = (int*)(lds + 16384 + 4 * 16 * 40 * 4);
    int* eb = ea + 64;
    const int tid = threadIdx.x, wid = __builtin_amdgcn_readfirstlane(tid >> 6), lane = tid & 63, kh = wid >> 2, tw = wid & 3;
    for (int unit = blockIdx.x; unit < T_TOK / 64; unit += gridDim.x) {
        int e0 = 0, e1 = 0; float w0 = 0.f, w1 = 0.f, rstd_t = 0.f;
        const int tok0 = unit * 64 + tw * 16, r = lane & 15, kq = lane >> 4;
        f32x4 acc0 = {0.f, 0.f, 0.f, 0.f}, acc1 = acc0, acc2 = acc0; float ss = 0.f;
        {
            const float* xr = X + (size_t)(tok0 + r) * DM + kh * 512 + 4 * kq;
            const int c2 = (32 + r < 36) ? 32 + r : 35;
            const float* wp0 = Wr + (size_t)r * 1024 + kh * 512 + 4 * kq; const float* wp1 = Wr + (size_t)(16 + r) * 1024 + kh * 512 + 4 * kq; const float* wp2 = Wr + (size_t)c2 * 1024 + kh * 512 + 4 * kq;
#pragma unroll 1
            for (int s = 0; s < 32; s += 4) {
                f32x4 xv[4], a0[4], a1[4], a2[4];
#pragma unroll
                for (int q = 0; q < 4; ++q) { xv[q] = *(const f32x4*)(xr + 16 * (s + q)); a0[q] = *(const f32x4*)(wp0 + 16 * (s + q)); a1[q] = *(const f32x4*)(wp1 + 16 * (s + q)); a2[q] = *(const f32x4*)(wp2 + 16 * (s + q)); }
#pragma unroll
                for (int q = 0; q < 4; ++q) {
                    ss += (xv[q][0] * xv[q][0] + xv[q][1] * xv[q][1]) + (xv[q][2] * xv[q][2] + xv[q][3] * xv[q][3]);
#pragma unroll
                    for (int uu = 0; uu < 4; ++uu) {
                        acc0 = __builtin_amdgcn_mfma_f32_16x16x4f32(xv[q][uu], a0[q][uu], acc0, 0, 0, 0);
                        acc1 = __builtin_amdgcn_mfma_f32_16x16x4f32(xv[q][uu], a1[q][uu], acc1, 0, 0, 0);
                        acc2 = __builtin_amdgcn_mfma_f32_16x16x4f32(xv[q][uu], a2[q][uu], acc2, 0, 0, 0);
                    }
                }
            }
            ss += __shfl_xor(ss, 16); ss += __shfl_xor(ss, 32);
        }
        if (kh == 1) { float* pp = part + (tw * 64 + lane) * 16;
            *(f32x4*)(pp) = acc0; *(f32x4*)(pp + 4) = acc1; *(f32x4*)(pp + 8) = acc2; pp[12] = ss; }
        __syncthreads();
        if (kh == 0) {
            const float* pp = part + (tw * 64 + lane) * 16;
            acc0 += *(const f32x4*)(pp); acc1 += *(const f32x4*)(pp + 4); acc2 += *(const f32x4*)(pp + 8); ss += pp[12];
            const float rstd = rsqrtf(ss * (1.f / DM) + EPS);
            float* lw = lg + tw * 16 * 40;
#pragma unroll
            for (int j = 0; j < 4; ++j) { const int trow = 4 * kq + j; lw[trow * 40 + r] = acc0[j]; lw[trow * 40 + 16 + r] = acc1[j]; if (r < 4) lw[trow * 40 + 32 + r] = acc2[j]; }
            asm volatile("s_waitcnt lgkmcnt(0)" ::: "memory");
            if (lane < 16) {
                const float* L = lw + lane * 40;
                float gl[4];
#pragma unroll
                for (int j = 0; j < 4; ++j) gl[j] = L[j] * rstd + bg[j];
                int gi = 0; float gm = gl[0];
#pragma unroll
                for (int j = 1; j < 4; ++j) if (gl[j] > gm) { gm = gl[j]; gi = j; }
                float den = 0.f;
#pragma unroll
                for (int j = 0; j < 4; ++j) den += __expf(gl[j] - gm);
                const float gprob = 1.f / den;
                float el[8];
#pragma unroll
                for (int j = 0; j < 8; ++j) el[j] = L[4 + 8 * gi + j] * rstd + be[8 * gi + j];
                int ia = 0; float ma = el[0];
#pragma unroll
                for (int j = 1; j < 8; ++j) if (el[j] > ma) { ma = el[j]; ia = j; }
                int ib = -1; float mb = -3.0e38f;
#pragma unroll
                for (int j = 0; j < 8; ++j) if (j != ia && el[j] > mb) { mb = el[j]; ib = j; }
                const float pb = __expf(mb - ma), inv = 1.f / (1.f + pb);
                w0 = gprob * inv; w1 = gprob * pb * inv; e0 = gi * 8 + ia; e1 = gi * 8 + ib; rstd_t = rstd;
                ea[tw * 16 + lane] = e0; eb[tw * 16 + lane] = e1;
            }
        }
        __syncthreads();
        if (kh == 0 && lane < 16) {
            const int t = tw * 16 + lane; int s0 = 0, s1 = 0;
            for (int q = 0; q < t; ++q) { const int qa = ea[q], qb = eb[q]; s0 += (qa == e0) + (qb == e0); s1 += (qa == e1) + (qb == e1); }
            TOKR[unit * 64 + t] = (u32x4){(unsigned)(e0 | (e1 << 8) | (s0 << 16) | (s1 << 24)), __float_as_uint(w0), __float_as_uint(w1), __float_as_uint(rstd_t)};
        }
        if (tid >= 256 && tid < 256 + NEXP) { const int e = tid - 256; unsigned c = 0; for (int q = 0; q < 64; ++q) c += (ea[q] == e) + (eb[q] == e); WH[unit * NEXP + e] = c; }
        __syncthreads();
    }
}

DEVI int build_tiles(const unsigned* cnt, int* tstart) {
    if (threadIdx.x == 0) { int acc = 0; for (int e = 0; e < NEXP; ++e) { tstart[e] = acc; acc += (int)((cnt[e] + 255u) >> 8); } tstart[NEXP] = acc; }
    __syncthreads();
    return tstart[NEXP];
}
DEVI void phase_gather(const Args& a, int layer, unsigned char* lds) {
    const unsigned* WH = (const unsigned*)(a.ws + WS_WH);
    const u32x4* TOKR = (const u32x4*)(a.ws + WS_TOKR);
    unsigned* CNT = (unsigned*)(a.ws + WS_CNT) + layer * 64;
    u32x4* RI = (u32x4*)(a.ws + WS_RI);
    int* tstart = (int*)lds;
    unsigned* cntl = (unsigned*)(lds + 256);
    unsigned* basel = cntl + 32;
    unsigned* ptot = (unsigned*)(lds + 1024);
    unsigned* pbas = ptot + 512;
    const int tid = threadIdx.x;
    for (int unit = blockIdx.x; unit < T_TOK / 64; unit += gridDim.x) {
        { const int e = tid & 31, part = tid >> 5; unsigned tot = 0, bs = 0;
#pragma unroll 4
          for (int q = 0; q < 16; ++q) { const int u = part * 16 + q; const unsigned c = WH[u * NEXP + e]; bs += (u < unit) ? c : 0u; tot += c; }
          ptot[part * 32 + e] = tot; pbas[part * 32 + e] = bs; }
        __syncthreads();
        if (tid < NEXP) { unsigned tot = 0, bs = 0;
#pragma unroll
            for (int q = 0; q < 16; ++q) { tot += ptot[q * 32 + tid]; bs += pbas[q * 32 + tid]; }
            cntl[tid] = tot; basel[tid] = bs; if (unit == 0) CNT[tid] = tot; }
        __syncthreads();
        build_tiles(cntl, tstart);
        if (tid < 128) { const int tok = unit * 64 + (tid >> 1), k = tid & 1;
            const u32x4 tr = TOKR[tok];
            const int e = (tr.x >> (8 * k)) & 0xff, sk = (tr.x >> (16 + 8 * k)) & 0xff;
            const size_t row = (size_t)tstart[e] * 256 + basel[e] + sk;
            RI[row] = (u32x4){(unsigned)(tok * 2 + k), k ? tr.z : tr.y, tr.w, (unsigned)tok}; }
        if (unit < NEXP) {
            const int e = unit; const size_t r0 = (size_t)tstart[e] * 256 + cntl[e], r1 = (size_t)tstart[e + 1] * 256;
            for (size_t row = r0 + tid; row < r1; row += NTHREADS) RI[row] = (u32x4){0xffffffffu, 0u, 0u, 0u};
        }
        __syncthreads();
    }
}
DEVI void phase_moe1(const Args& a, int layer, unsigned char* lds) {
    const unsigned* cnt = (const unsigned*)(a.ws + WS_CNT) + layer * 64;
    int* tstart = (int*)(lds + TS_OFF); const int NT = build_tiles(cnt, tstart);
    SchedMoE S{(const bf16_t*)(a.ws + WS_XB), (const bf16_t*)(a.ws + WS_W1) + (size_t)layer * NEXP * 1024 * 1024, tstart, 0, 1024, NT, (int)gridDim.x, (int)blockIdx.x};
    EpiSwiGLU E{(const u32x4*)(a.ws + WS_RI), (bf16_t*)(a.ws + WS_H)};
    pg8::gemm_phase_gather((LAS unsigned char*)lds, GemmDesc{1024, 1024, 1024}, S, E, (const u32x4*)(a.ws + WS_RI));
}
DEVI void phase_moe2(const Args& a, int layer, unsigned char* lds) {
    const unsigned* cnt = (const unsigned*)(a.ws + WS_CNT) + layer * 64;
    int* tstart = (int*)(lds + TS_OFF); const int NT = build_tiles(cnt, tstart);
    SchedMoE S{(const bf16_t*)(a.ws + WS_H), (const bf16_t*)(a.ws + WS_W2) + (size_t)layer * NEXP * 1024 * 512, tstart, 512, 512, NT, (int)gridDim.x, (int)blockIdx.x};
    EpiMoeDown E{(const u32x4*)(a.ws + WS_RI), (bf16_t*)(a.ws + WS_Y)};
#if (NAIVE_MASK >> 6) & 1u
    { Unit u; const u32x4* RI = (const u32x4*)(a.ws + WS_RI); bf16_t* Y = (bf16_t*)(a.ws + WS_Y);
      for (int i = 0; S.next(i, u); ++i) {
        for (int it = threadIdx.x; it < 256 * 32; it += NTHREADS) {
            const int r = it >> 5, cg = (it & 31) * 8;
            const bf16_t* hrow = u.A + (size_t)r * 512; const bf16_t* wrow = u.B + (size_t)cg * 512;
            float acc[8] = {0.f, 0.f, 0.f, 0.f, 0.f, 0.f, 0.f, 0.f};
            for (int k = 0; k < 512; ++k) { const float h = bf2f(hrow[k]);
#pragma unroll
                for (int jj = 0; jj < 8; ++jj) acc[jj] += h * bf2f(wrow[(size_t)jj * 512 + k]); }
            const size_t row = (size_t)u.pm * 256 + r; const u32x4 ri = RI[row]; const int dest = (int)ri.x; const float w = __uint_as_float(ri.y);
            if (dest >= 0) { u32x4 o; o.x = cvt_pk(acc[0] * w, acc[1] * w); o.y = cvt_pk(acc[2] * w, acc[3] * w); o.z = cvt_pk(acc[4] * w, acc[5] * w); o.w = cvt_pk(acc[6] * w, acc[7] * w);
                *(u32x4*)(Y + ((size_t)(dest & 1) * T_TOK + (size_t)(dest >> 1)) * DM + u.pn * 256 + cg) = o; }
        }
      } }
#else
    GEMM_PHASE(6, (GemmDesc{512, 512, 512}), S, E);
#endif
}
template <bool FINAL>
DEVI void phase_resid(const Args& a) {
    float* X = (float*)(a.ws + WS_X); const bf16_t* Y = (const bf16_t*)(a.ws + WS_Y); bf16_t* XB = (bf16_t*)(a.ws + WS_XB); float* RS2 = (float*)(a.ws + WS_RS2);
    const int wid = threadIdx.x >> 6, lane = threadIdx.x & 63;
    for (int row = blockIdx.x * NWAVES + wid; row < T_TOK; row += gridDim.x * NWAVES) {
        f32x4 v[4]; float s = 0.f;
#pragma unroll
        for (int j = 0; j < 4; ++j) {
            const size_t off = (size_t)row * DM + 256 * j + 4 * lane;
            v[j] = *(const f32x4*)(X + off);
            const u32x2 y0 = *(const u32x2*)(Y + off), y1 = *(const u32x2*)(Y + (size_t)T_TOK * DM + off);
            v[j][0] += bflo(y0.x) + bflo(y1.x); v[j][1] += bfhi(y0.x) + bfhi(y1.x); v[j][2] += bflo(y0.y) + bflo(y1.y); v[j][3] += bfhi(y0.y) + bfhi(y1.y);
            s += (v[j][0] * v[j][0] + v[j][1] * v[j][1]) + (v[j][2] * v[j][2] + v[j][3] * v[j][3]);
        }
        const float rstd = rsqrtf(wave_sum(s) * (1.f / DM) + EPS);
#pragma unroll
        for (int j = 0; j < 4; ++j) {
            const size_t off = (size_t)row * DM + 256 * j + 4 * lane;
            if (FINAL) { const f32x4 g = *(const f32x4*)(a.in[23] + 256 * j + 4 * lane); *(f32x4*)(a.out + off) = v[j] * rstd * g; }
            else { *(f32x4*)(X + off) = v[j]; u32x2 w; w.x = cvt_pk(v[j][0], v[j][1]); w.y = cvt_pk(v[j][2], v[j][3]); *(u32x2*)(XB + off) = w; }
        }
        if (!FINAL && lane == 0) RS2[row] = rstd;
    }
}

DEVI void phase_attn_naive(const Args& a, unsigned char* lds) {
    const bf16_t* Q = (const bf16_t*)(a.ws + WS_Q); const bf16_t* KN = (const bf16_t*)(a.ws + WS_KN); const bf16_t* KR = (const bf16_t*)(a.ws + WS_KR);
    const bf16_t* V = (const bf16_t*)(a.ws + WS_V); bf16_t* O = (bf16_t*)(a.ws + WS_O);
    const int wid = threadIdx.x >> 6, lane = threadIdx.x & 63;
    float* qs = (float*)lds + wid * DQK;
    for (int unit = blockIdx.x; unit < 2 * NH * (SEQ / 8); unit += gridDim.x) {
        const int bh = unit >> 10, s = (unit & 1023) * 8 + wid, b = bh >> 3, h = bh & 7;
        const bf16_t* qp = Q + ((size_t)bh * SEQ + s) * DQK;
        for (int i = lane; i < DQK; i += 64) qs[i] = bf2f(qp[i]);
        asm volatile("s_waitcnt lgkmcnt(0)" ::: "memory");
        const int nt = (s >> 6) + 1; float m = -1e30f, l = 0.f, o0 = 0.f, o1 = 0.f;
        for (int jt = 0; jt < nt; ++jt) {
            const int key = jt * 64 + lane;
            const bf16_t* kn = KN + ((size_t)bh * SEQ + key) * DNOPE; const bf16_t* kr = KR + ((size_t)b * SEQ + key) * DROPE;
            float sc = 0.f;
            for (int d = 0; d < DNOPE; d += 8) { const u32x4 kv = *(const u32x4*)(kn + d); const f32x4 q0 = *(const f32x4*)(qs + d), q1 = *(const f32x4*)(qs + d + 4);
                sc += q0[0] * bflo(kv.x) + q0[1] * bfhi(kv.x) + q0[2] * bflo(kv.y) + q0[3] * bfhi(kv.y) + q1[0] * bflo(kv.z) + q1[1] * bfhi(kv.z) + q1[2] * bflo(kv.w) + q1[3] * bfhi(kv.w); }
            for (int d = 0; d < DROPE; d += 8) { const u32x4 kv = *(const u32x4*)(kr + d); const f32x4 q0 = *(const f32x4*)(qs + DNOPE + d), q1 = *(const f32x4*)(qs + DNOPE + d + 4);
                sc += q0[0] * bflo(kv.x) + q0[1] * bfhi(kv.x) + q0[2] * bflo(kv.y) + q0[3] * bfhi(kv.y) + q1[0] * bflo(kv.z) + q1[1] * bfhi(kv.z) + q1[2] * bflo(kv.w) + q1[3] * bfhi(kv.w); }
            const float mn = fmaxf(m, wave_max(sc)), alpha = __builtin_amdgcn_exp2f(m - mn), p = __builtin_amdgcn_exp2f(sc - mn);
            l = l * alpha + wave_sum(p); o0 *= alpha; o1 *= alpha; m = mn;
            const bf16_t* vp = V + ((size_t)bh * SEQ + jt * 64) * DV + 2 * lane;
            for (int j = 0; j < 64; ++j) { const float pj = __shfl(p, j); const unsigned vv = *(const unsigned*)(vp + j * DV); o0 += pj * bflo(vv); o1 += pj * bfhi(vv); }
        }
        const float il = 1.f / l;
        *(unsigned*)(O + ((size_t)b * SEQ + s) * DM + h * DV + 2 * lane) = cvt_pk(o0 * il, o1 * il);
        asm volatile("s_waitcnt lgkmcnt(0)" ::: "memory");
    }
}

namespace att {
typedef short s16x4 __attribute__((ext_vector_type(4)));
typedef float f32x16 __attribute__((ext_vector_type(16)));
constexpr int SHM_KN = 16384, SHM_KR = 8192, SHM_V = 16384;
constexpr int OFF_V = 0, OFF_KN = 32768, OFF_KR = 65536, OFF_WS = 81920, OFF_QR = 83968;
constexpr float THR2 = 11.0f;
#define KSWZ(row, colB) ((row) * 256 + ((colB) ^ (((row) & 7) << 4)))
#define RSWZ(row, colB) ((row) * 128 + ((colB) ^ ((((row) >> 1) & 7) << 4)))
#define SBAR() __builtin_amdgcn_sched_barrier(0)
DEVI int v_st(int k, int c) { const int kk = (k & ~0xC) | ((k & 4) << 1) | ((k & 8) >> 1); return ((kk >> 3) * 4 + (c >> 5)) * 512 + ((kk & 7) * 32 + (c & 31)) * 2; }
DEVI int v_rd_base(int lane) { return ((lane & 3) << 3) | (((lane >> 2) & 3) << 6) | (((lane >> 4) & 1) << 5) | (((lane >> 5) & 1) << 8); }
constexpr int v_rd_off(int d0, int ks, int half) { return d0 * 512 + ks * 4096 + half * 2048; }
DEVI int crow(int r, int hi) { return (r & 3) + 8 * (r >> 2) + 4 * hi; }

constexpr int NQR = 6;
template <int KB>
DEVI void qkt(f32x16& p0, f32x16& p1, const char* lds, int r32, int hi, const bf16x8* qr, const char* qlds) {
    p0 = f32x16{}; p1 = f32x16{};
    const char* kb[4]; const char* kr[4];
#pragma unroll
    for (int dd = 0; dd < 4; ++dd) { kb[dd] = lds + OFF_KN + KB * SHM_KN + KSWZ(r32, (dd * 16 + hi * 8) * 2); kr[dd] = lds + OFF_KR + KB * SHM_KR + RSWZ(r32, (dd * 16 + hi * 8) * 2); }
#pragma unroll
    for (int d0 = 0; d0 < 8; ++d0) { const char* a = kb[d0 & 3] + (d0 >> 2) * 128;
        const bf16x8 b0 = *reinterpret_cast<const bf16x8*>(a), b1 = *reinterpret_cast<const bf16x8*>(a + 32 * 256);
        bf16x8 qv; if (d0 < NQR) qv = qr[d0]; else qv = *reinterpret_cast<const bf16x8*>(qlds + (d0 - NQR) * 1024);
        p0 = __builtin_amdgcn_mfma_f32_32x32x16_bf16(b0, qv, p0, 0, 0, 0);
        p1 = __builtin_amdgcn_mfma_f32_32x32x16_bf16(b1, qv, p1, 0, 0, 0); }
#pragma unroll
    for (int d0 = 0; d0 < 4; ++d0) { const char* a = kr[d0];
        const bf16x8 b0 = *reinterpret_cast<const bf16x8*>(a), b1 = *reinterpret_cast<const bf16x8*>(a + 32 * 128);
        const bf16x8 qv = *reinterpret_cast<const bf16x8*>(qlds + (8 + d0 - NQR) * 1024);
        p0 = __builtin_amdgcn_mfma_f32_32x32x16_bf16(b0, qv, p0, 0, 0, 0);
        p1 = __builtin_amdgcn_mfma_f32_32x32x16_bf16(b1, qv, p1, 0, 0, 0); }
}
template <int VB>
DEVI void pv_tile(f32x16* o, int vb0, bf16x8 pa0, bf16x8 pa1, bf16x8 pa2, bf16x8 pa3) {
#define TRRD(dst, off) asm volatile("ds_read_b64_tr_b16 %0, %1 offset:%2" : "=&v"(dst) : "v"(vb0), "i"(off) : "memory")
#define PV_D0(d0) do { s16x4 l0, l1, l2, l3, h0, h1, h2, h3; constexpr int b_ = OFF_V + VB * SHM_V + v_rd_off(d0, 0, 0); \
        TRRD(l0, b_); TRRD(h0, b_ + 2048); TRRD(l1, b_ + 4096); TRRD(h1, b_ + 6144); TRRD(l2, b_ + 8192); TRRD(h2, b_ + 10240); TRRD(l3, b_ + 12288); TRRD(h3, b_ + 14336); \
        asm volatile("s_waitcnt lgkmcnt(0)" ::: "memory"); SBAR(); \
        o[d0] = __builtin_amdgcn_mfma_f32_32x32x16_bf16(pa0, (bf16x8){l0[0], l0[1], l0[2], l0[3], h0[0], h0[1], h0[2], h0[3]}, o[d0], 0, 0, 0); \
        o[d0] = __builtin_amdgcn_mfma_f32_32x32x16_bf16(pa1, (bf16x8){l1[0], l1[1], l1[2], l1[3], h1[0], h1[1], h1[2], h1[3]}, o[d0], 0, 0, 0); \
        o[d0] = __builtin_amdgcn_mfma_f32_32x32x16_bf16(pa2, (bf16x8){l2[0], l2[1], l2[2], l2[3], h2[0], h2[1], h2[2], h2[3]}, o[d0], 0, 0, 0); \
        o[d0] = __builtin_amdgcn_mfma_f32_32x32x16_bf16(pa3, (bf16x8){l3[0], l3[1], l3[2], l3[3], h3[0], h3[1], h3[2], h3[3]}, o[d0], 0, 0, 0); } while (0)
    PV_D0(0); PV_D0(1); PV_D0(2); PV_D0(3);
#undef PV_D0
#undef TRRD
}
DEVI void softmax_tile(f32x16& p0, f32x16& p1, float& m_reg, float& l_reg, float& alpha, bf16x8& pa0, bf16x8& pa1, bf16x8& pa2, bf16x8& pa3) {
    float pmax = p0[0];
#pragma unroll
    for (int r = 1; r < 16; ++r) pmax = fmaxf(pmax, p0[r]);
#pragma unroll
    for (int r = 0; r < 16; ++r) pmax = fmaxf(pmax, p1[r]);
    { auto rr = __builtin_amdgcn_permlane32_swap(__float_as_uint(pmax), __float_as_uint(pmax), false, false); pmax = fmaxf(__uint_as_float(rr[0]), __uint_as_float(rr[1])); }
    float mn;
    if (__builtin_expect(__all((pmax - m_reg) <= THR2), 1)) { mn = m_reg; alpha = 1.f; }
    else { mn = fmaxf(m_reg, pmax); alpha = __builtin_amdgcn_exp2f(m_reg - mn); m_reg = mn; }
#pragma unroll
    for (int r = 0; r < 16; ++r) { p0[r] = __builtin_amdgcn_exp2f(p0[r] - mn); p1[r] = __builtin_amdgcn_exp2f(p1[r] - mn); }
    float ps = 0.f;
#pragma unroll
    for (int r = 0; r < 16; ++r) ps += p0[r];
#pragma unroll
    for (int r = 0; r < 16; ++r) ps += p1[r];
    { auto rr = __builtin_amdgcn_permlane32_swap(__float_as_uint(ps), __float_as_uint(ps), false, false); ps = __uint_as_float(rr[0]) + __uint_as_float(rr[1]); }
    l_reg = l_reg * alpha + ps;
#define PK4(P, B_, OUT) do { unsigned a0 = cvt_pk(P[B_ + 0], P[B_ + 1]), a1 = cvt_pk(P[B_ + 2], P[B_ + 3]); \
        unsigned b0 = cvt_pk(P[B_ + 4], P[B_ + 5]), b1 = cvt_pk(P[B_ + 6], P[B_ + 7]); \
        auto r0 = __builtin_amdgcn_permlane32_swap(a0, b0, false, false); auto r1 = __builtin_amdgcn_permlane32_swap(a1, b1, false, false); \
        u32x4 w = {r0[0], r1[0], r0[1], r1[1]}; OUT = *reinterpret_cast<bf16x8*>(&w); } while (0)
    PK4(p0, 0, pa0); PK4(p0, 8, pa1); PK4(p1, 0, pa2); PK4(p1, 8, pa3);
#undef PK4
}

DEVI void attn_unit(int b, int h, int qb, const bf16_t* Q, const bf16_t* KN, const bf16_t* KR, const bf16_t* V, bf16_t* O, char* lds) {
    const int tid = threadIdx.x, wid = __builtin_amdgcn_readfirstlane(tid >> 6), lane = tid & 63, r32 = lane & 31, hi = lane >> 5;
    const int bh = b * NH + h, q0 = qb * 256, NT = 4 * qb + 4, wch = 4 * qb + (wid >> 1);
    const bf16_t* Kh = KN + (size_t)bh * SEQ * DNOPE; const bf16_t* Vh = V + (size_t)bh * SEQ * DV; const bf16_t* Rh = KR + (size_t)b * SEQ * DROPE;
    float* ws = (float*)(lds + OFF_WS) + wid * 64; float* li_l = ws; float* al_l = ws + 32;
    bf16x8 qr[NQR]; char* qlds = lds + OFF_QR + wid * ((12 - NQR) * 1024) + lane * 16;
#define BLD(rs, vo, so) __builtin_bit_cast(bf16x8, __builtin_amdgcn_raw_buffer_load_b128(rs, vo, so, 0))
    { const __amdgpu_buffer_rsrc_t rsQ = __builtin_amdgcn_make_buffer_rsrc((void*)(Q + ((size_t)bh * SEQ + q0 + wid * 32) * DQK), 0, 32 * DQK * 2, 0x00020000);
      const unsigned qo = (unsigned)(r32 * DQK + hi * 8) * 2u;
#pragma unroll
      for (int d0 = 0; d0 < NQR; ++d0) qr[d0] = BLD(rsQ, qo, d0 * 32);
#pragma unroll
      for (int d0 = NQR; d0 < 12; ++d0) *reinterpret_cast<bf16x8*>(qlds + (d0 - NQR) * 1024) = BLD(rsQ, qo, d0 * 32); }
    const int sr = tid >> 4, sc = (tid & 15) * 8, kws = OFF_KN + KSWZ(sr, sc * 2), vst0 = OFF_V + v_st(sr, sc), vst1 = OFF_V + v_st(32 + sr, sc);
    const int rr_ = tid >> 3, rc = (tid & 7) * 8, rws = OFF_KR + RSWZ(rr_, rc * 2);
    const int vb0 = (int)(uintptr_t)lds + v_rd_base(lane);
    bf16x8 st_k0, st_k1, st_v0, st_v1, st_r;
    const __amdgpu_buffer_rsrc_t rsK = __builtin_amdgcn_make_buffer_rsrc((void*)Kh, 0, SEQ * DNOPE * 2, 0x00020000);
    const __amdgpu_buffer_rsrc_t rsV = __builtin_amdgcn_make_buffer_rsrc((void*)Vh, 0, SEQ * DV * 2, 0x00020000);
    const __amdgpu_buffer_rsrc_t rsR = __builtin_amdgcn_make_buffer_rsrc((void*)Rh, 0, SEQ * DROPE * 2, 0x00020000);
    const unsigned kvoff = (unsigned)(sr * 128 + sc) * 2u, roff = (unsigned)(rr_ * 64 + rc) * 2u;
#define SLOAD(t) do { const unsigned so_ = (unsigned)(t) * (64u * 256u); \
        st_k0 = BLD(rsK, kvoff, so_); st_k1 = BLD(rsK, kvoff, so_ + 8192u); st_v0 = BLD(rsV, kvoff, so_); st_v1 = BLD(rsV, kvoff, so_ + 8192u); \
        st_r = BLD(rsR, roff, (unsigned)(t) * (64u * 128u)); } while (0)
#define SWRITE(bf) do { *reinterpret_cast<bf16x8*>(lds + (bf) * SHM_KN + kws) = st_k0; *reinterpret_cast<bf16x8*>(lds + (bf) * SHM_KN + kws + 32 * 256) = st_k1; \
        *reinterpret_cast<bf16x8*>(lds + (bf) * SHM_V + vst0) = st_v0; *reinterpret_cast<bf16x8*>(lds + (bf) * SHM_V + vst1) = st_v1; \
        *reinterpret_cast<bf16x8*>(lds + (bf) * SHM_KR + rws) = st_r; } while (0)
    float m_reg = -1e30f, l_reg = 0.f; f32x16 o[4] = {};
    SLOAD(0); SWRITE(0);
    __syncthreads();
#define STEP(KB, t, more) do { \
        if (more) SLOAD((t) + 1); \
        if ((t) <= wch) { \
            f32x16 p0, p1; float alpha; bf16x8 pa0, pa1, pa2, pa3; \
            qkt<KB>(p0, p1, lds, r32, hi, qr, qlds); \
            softmax_tile(p0, p1, m_reg, l_reg, alpha, pa0, pa1, pa2, pa3); \
            if (__any(alpha < 1.f)) { if (hi == 0) al_l[r32] = alpha; asm volatile("s_waitcnt lgkmcnt(0)" ::: "memory"); \
                _Pragma("unroll") for (int d_ = 0; d_ < 4; ++d_) _Pragma("unroll") for (int r = 0; r < 16; ++r) o[d_][r] *= al_l[crow(r, hi)]; } \
            pv_tile<KB>(o, vb0, pa0, pa1, pa2, pa3); \
        } \
        if (more) SWRITE(1 - (KB)); \
        __syncthreads(); } while (0)
    for (int t = 0; t < NT; t += 2) {
        STEP(0, t, true);
        STEP(1, t + 1, (t + 2 < NT));
    }
    if (hi == 0) li_l[r32] = l_reg;
    asm volatile("s_waitcnt lgkmcnt(0)" ::: "memory");
    const __amdgpu_buffer_rsrc_t rsO = __builtin_amdgcn_make_buffer_rsrc((void*)(O + ((size_t)b * SEQ + q0 + wid * 32) * DM + h * DV), 0, 32 * DM * 2, 0x00020000);
#pragma unroll
    for (int r = 0; r < 16; ++r) { const int orow = crow(r, hi); const float il = __builtin_amdgcn_rcpf(li_l[orow]);
#pragma unroll
        for (int d0 = 0; d0 < 4; ++d0) { const float v = o[d0][r] * il; const float vn = __shfl_xor(v, 1);
            if ((r32 & 1) == 0) __builtin_amdgcn_raw_buffer_store_b32(cvt_pk(v, vn), rsO, (unsigned)(orow * DM + d0 * 32 + r32) * 2u, 0, 0); } }
#undef BLD
#undef SLOAD
#undef SWRITE
#undef STEP
}
}

DEVI void phase_attn(const Args& a, unsigned char* lds) {
    const bf16_t* Q = (const bf16_t*)(a.ws + WS_Q); const bf16_t* KN = (const bf16_t*)(a.ws + WS_KN); const bf16_t* KR = (const bf16_t*)(a.ws + WS_KR);
    const bf16_t* V = (const bf16_t*)(a.ws + WS_V); bf16_t* O = (bf16_t*)(a.ws + WS_O);
    for (int item = blockIdx.x; item < 2 * NH * 16; item += gridDim.x) {
        const int bh = item >> 4, x = item & 15, b = bh >> 3, h = bh & 7;
        att::attn_unit(b, h, 31 - x, Q, KN, KR, V, O, (char*)lds);
        __syncthreads();
        att::attn_unit(b, h, x, Q, KN, KR, V, O, (char*)lds);
        __syncthreads();
    }
}

#define XB_TMO      128
#define XB_XCNT(j)  (256  + 64 * (j))
#define XB_XSUB(j)  (1280 + 64 * (j))
#define XB_XGEN(j)  (2304 + 64 * (j))
#define XB_TOP      3328
#define XB_TOPGEN   3392
#define XCD_BAR_WORDS 3456
#define XB_SPIN_CAP (1u << 18)
__device__ __forceinline__ unsigned xb_ld(unsigned* p)              { return __hip_atomic_load(p, __ATOMIC_RELAXED, __HIP_MEMORY_SCOPE_AGENT); }
__device__ __forceinline__ unsigned xb_add(unsigned* p, unsigned v) { return __hip_atomic_fetch_add(p, v, __ATOMIC_RELAXED, __HIP_MEMORY_SCOPE_AGENT); }
__device__ __forceinline__ unsigned xb_xcc_id() { return (unsigned)__builtin_amdgcn_s_getreg((3 << 11) | 20) & 0xFu; }
#define XB_SPIN(cond, bar) do { unsigned _sp = 0; while (cond) { __builtin_amdgcn_s_sleep(1); \
    if ((++_sp & 255u) == 0u) { if (xb_ld(&(bar)[XB_TMO])) break; if (_sp > XB_SPIN_CAP) { atomicAdd(&(bar)[XB_TMO], 1u); break; } } } } while (0)
struct XcdBarrier { unsigned* bar; unsigned x; volatile LAS unsigned* st; };
__device__ __forceinline__ XcdBarrier xcd_barrier_post(unsigned* bar, volatile LAS unsigned* st) {
    XcdBarrier b; b.bar = bar; b.x = xb_xcc_id(); b.st = st;
    if (threadIdx.x == 0) (void)xb_add(&bar[XB_XCNT(b.x)], 1u);
    return b;
}
__device__ __forceinline__ void xcd_barrier_complete(unsigned* bar, unsigned x, unsigned& nloc, unsigned& nx) {
    const unsigned G = gridDim.x * gridDim.y * gridDim.z;
    unsigned sum, cnt, mine, sp = 0u;
    for (;;) {
        sum = 0u; cnt = 0u; mine = 0u;
#pragma unroll
        for (unsigned j = 0; j < 16; ++j) { const unsigned c = xb_ld(&bar[XB_XCNT(j)]); sum += c; cnt += (c > 0u) ? 1u : 0u; mine = (j == x) ? c : mine; }
        if (sum == G) break;
        __builtin_amdgcn_s_sleep(1);
        if ((++sp & 255u) == 0u) { if (xb_ld(&bar[XB_TMO])) break; if (sp > XB_SPIN_CAP) { atomicAdd(&bar[XB_TMO], 1u); break; } }
    }
    nloc = mine > 0u ? mine : 1u; nx = cnt > 0u ? cnt : 1u;
}
__device__ __forceinline__ void xcd_barrier(const XcdBarrier& b) {
    asm volatile("s_waitcnt vmcnt(0)" ::: "memory");
    __syncthreads();
    if (threadIdx.x == 0) {
        unsigned* bar = b.bar;
        __builtin_amdgcn_s_waitcnt(0);
        unsigned nloc = b.st[0], nx = b.st[1];
        if (nloc == 0u) { xcd_barrier_complete(bar, b.x, nloc, nx); b.st[0] = nloc; b.st[1] = nx; }
        const unsigned old = xb_add(&bar[XB_XSUB(b.x)], 1u);
        const unsigned gen = old / nloc;
        if (old + 1u == (gen + 1u) * nloc) {
            __builtin_amdgcn_fence(__ATOMIC_RELEASE, "agent");
            asm volatile("s_waitcnt vmcnt(0)" ::: "memory");
            const unsigned og = xb_add(&bar[XB_TOP], 1u);
            const unsigned tg = og / nx;
            if (og + 1u == (tg + 1u) * nx) xb_add(&bar[XB_TOPGEN], 1u);
            else XB_SPIN(xb_ld(&bar[XB_TOPGEN]) == tg, bar);
            __builtin_amdgcn_fence(__ATOMIC_ACQUIRE, "agent");
            xb_add(&bar[XB_XGEN(b.x)], 1u);
            asm volatile("s_waitcnt vmcnt(0)" ::: "memory");
        } else {
            XB_SPIN(xb_ld(&bar[XB_XGEN(b.x)]) == gen, bar);
            __builtin_amdgcn_fence(__ATOMIC_ACQUIRE, "agent");
            asm volatile("s_waitcnt vmcnt(0)" ::: "memory");
        }
    }
    __syncthreads();
}

constexpr int NPHASES = 17;
__global__ void __launch_bounds__(NTHREADS, 2) fwd(Args a) {
    extern __shared__ __attribute__((aligned(16))) unsigned char lds[];
    unsigned char* ws = a.ws;
    const int lo = a.ph_lo, hi = a.ph_hi, G = gridDim.x, c = blockIdx.x;
    volatile LAS unsigned* misc = (volatile LAS unsigned*)((LAS unsigned char*)lds + MISC_OFF);
    if (threadIdx.x < 16) misc[threadIdx.x] = 0u;
    __syncthreads();
    XcdBarrier bar; bar.bar = (unsigned*)(ws + WS_CTL) + CW_BAR; bar.x = 0; bar.st = misc;
    if (hi - lo > 1) bar = xcd_barrier_post((unsigned*)(ws + WS_CTL) + CW_BAR, misc);
#ifndef PHMASK
#define PHMASK 0xFFFFFFFFu
#endif
#define IN(k) (((PHMASK >> (k)) & 1u) && lo <= (k) && (k) < hi)
#define SEAM(k) do { if (IN(k) && IN((k) + 1)) xcd_barrier(bar); } while (0)
#ifndef REPEAT_MASK
#define REPEAT_MASK 0x0u
#endif
#define REP(k, body) do { if ((REPEAT_MASK >> (k)) & 1u) { xcd_barrier(bar); body; } } while (0)
    if (IN(0)) { phase_prologue(a, lds); phase_pool_prep(a, lds); }
    REP(0, phase_prologue(a, lds));
    REP(1, phase_pool_prep(a, lds));
    SEAM(0);
    if (IN(2)) {
        SchedDense S{(const bf16_t*)(ws + WS_PB), (const bf16_t*)(ws + WS_WPOOL), 1024, 64, 4, G, c, 256, 65536};
        EpiPool E{a.in[0], (const float*)(ws + WS_PBIAS), (float*)(ws + WS_X), (bf16_t*)(ws + WS_XB)};
        GEMM_PHASE(2, (GemmDesc{1024, 256, 256}), S, E);
    }
    SEAM(2);
    if (IN(3)) phase_route(a, 0, lds);
    REP(3, phase_route(a, 0, lds));
    SEAM(3);
    if (IN(4)) phase_gather(a, 0, lds);
    REP(4, phase_gather(a, 0, lds));
    SEAM(4);
    if (IN(5)) phase_moe1(a, 0, lds);
    REP(5, phase_moe1(a, 0, lds));
    SEAM(5);
    if (IN(6)) phase_moe2(a, 0, lds);
    REP(6, phase_moe2(a, 0, lds));
    SEAM(6);
    if (IN(7)) phase_resid<false>(a);
    SEAM(7);
    if (IN(8)) {
        SchedDense S{(const bf16_t*)(ws + WS_XB), (const bf16_t*)(ws + WS_WDOWN), 1024, 64, 3, G, c, 0, (size_t)256 * 1024};
        const float* rc = (const float*)(ws + WS_ROPE);
        EpiDownProj E{(const float*)(ws + WS_RS2), (bf16_t*)(ws + WS_CKV), (bf16_t*)(ws + WS_CQ), (bf16_t*)(ws + WS_KR), (float*)(ws + WS_SSKV), (float*)(ws + WS_SSQ), rc, rc + SEQ * 32};
        GEMM_PHASE(8, (GemmDesc{1024, 1024, 1024}), S, E);
    }
    SEAM(8);
    if (IN(9)) {
        { SchedDense S{(const bf16_t*)(ws + WS_CKV), (const bf16_t*)(ws + WS_WUPKV), 256, 64, 8, G, c, 0, (size_t)256 * 256};
          EpiUpKV E{(const float*)(ws + WS_SSKV), (bf16_t*)(ws + WS_KN), (bf16_t*)(ws + WS_V)};
          GEMM_PHASE(9, (GemmDesc{256, 256, 256}), S, E); }
        { SchedDense S{(const bf16_t*)(ws + WS_CQ), (const bf16_t*)(ws + WS_WUPQ), 384, 64, 6, G, c, 0, (size_t)256 * 384};
          const float* rc = (const float*)(ws + WS_ROPE);
          EpiUpQ E{(const float*)(ws + WS_SSQ), (bf16_t*)(ws + WS_Q), rc, rc + SEQ * 32};
          GEMM_PHASE(10, (GemmDesc{384, 384, 384}), S, E); }
    }
    SEAM(9);
#ifdef NAIVE_ATTN
    if (IN(10)) phase_attn_naive(a, lds);
#else
    if (IN(10)) phase_attn(a, lds);
    REP(10, phase_attn(a, lds));
#endif
    SEAM(10);
    if (IN(11)) {
        SchedDense S{(const bf16_t*)(ws + WS_O), (const bf16_t*)(ws + WS_WO), 1024, 64, 4, G, c, 0, (size_t)256 * 1024};
        EpiWo E{(float*)(ws + WS_X), (bf16_t*)(ws + WS_XB)};
        GEMM_PHASE(11, (GemmDesc{1024, 1024, 1024}), S, E);
    }
    SEAM(11);
    if (IN(12)) phase_route(a, 1, lds);
    SEAM(12);
    if (IN(13)) phase_gather(a, 1, lds);
    SEAM(13);
    if (IN(14)) phase_moe1(a, 1, lds);
    SEAM(14);
    if (IN(15)) phase_moe2(a, 1, lds);
    SEAM(15);
    if (IN(16)) phase_resid<true>(a);
    REP(16, phase_resid<true>(a));
#undef IN
#undef SEAM
}

extern "C" void kernel_launch(void* const* d_in, const int* in_sizes, int n_in, void* d_out, int out_size, void* d_ws, size_t ws_size, hipStream_t stream) {
    static int grid = 0;
    if (grid == 0) {
        if (n_in != 24 || ws_size < WS_END) { fprintf(stderr, "kernel_launch: unexpected n_in %d / ws_size %zu\n", n_in, ws_size); grid = -1; return; }
        int dev = 0, cus = 0;
        if (hipGetDevice(&dev) != hipSuccess || hipDeviceGetAttribute(&cus, hipDeviceAttributeMultiprocessorCount, dev) != hipSuccess || cus <= 0) cus = 256;
        if (hipFuncSetAttribute((const void*)fwd, hipFuncAttributeMaxDynamicSharedMemorySize, LDS_BYTES) != hipSuccess) { fprintf(stderr, "hipFuncSetAttribute failed\n"); grid = -1; return; }
        grid = cus;
    }
    if (grid < 0) return;
    (void)hipMemsetAsync((char*)d_ws + WS_CTL, 0, CTL_ZERO_BYTES, stream);
    Args a{};
    for (int i = 0; i < 24; ++i) a.in[i] = (const float*)d_in[i];
    a.out = (float*)d_out; a.ws = (unsigned char*)d_ws;
#ifndef PROBE_LAST
#define PROBE_LAST 15
#endif
    a.ph_lo = 0; a.ph_hi = NPHASES; a.li = 0; a.pad = 0;
    hipLaunchKernelGGL(fwd, dim3(grid), dim3(NTHREADS), LDS_BYTES, stream, a);
}
```
